# Optimizing an MI355X kernel written in HIP

```python
import jax, jax.numpy as jnp
from jax import lax
import numpy as np

D_MODEL = 1024
BATCH = 8
SEQ = 2048
DEPTH = 2

CHUNK = 64
Q_BLOCK = 128
CONV_WIDTH = 1024
CONV_GROUPS = 16
CONV_K = 3
MLA_HEADS = 16
QK_NOPE = 64
QK_ROPE = 32
V_DIM = 64
Q_LORA = 256
KV_LORA = 128
ROPE_THETA = 10000.0
N_BRANCH = 2
D_FF_DENSE = 2816
N_EXPERTS = 8
TOP_K = 2
D_FF_EXPERT = 1792
N_DENSE = (DEPTH + 1) // 2
N_MOE = DEPTH // 2
EPS = 1e-6
IN_SIZES = (CONV_WIDTH, CONV_WIDTH, CONV_WIDTH, Q_LORA, KV_LORA + QK_ROPE, N_BRANCH * D_MODEL)
IN_COLS = sum(IN_SIZES)

kernel_name = "hybrid_shortconv_mla_moe_trunk"


def rmsnorm(x, g):
    xf = x.astype(jnp.float32)
    inv = lax.rsqrt(jnp.mean(xf * xf, axis=-1, keepdims=True) + EPS)
    return (xf * inv).astype(x.dtype) * g


def rope_tables(positions):
    inv_freq = ROPE_THETA ** (-jnp.arange(0, QK_ROPE, 2, dtype=jnp.float32) / QK_ROPE)
    ang = positions.astype(jnp.float32)[..., None] * inv_freq
    return jnp.cos(ang), jnp.sin(ang)


def apply_rope(t, cos, sin):
    t1, t2 = jnp.split(t, 2, axis=-1)
    cos = cos.astype(t.dtype)
    sin = sin.astype(t.dtype)
    return jnp.concatenate([t1 * cos - t2 * sin, t1 * sin + t2 * cos], axis=-1)


def short_conv_mixer(gate_b, gate_c, u, conv_w, w_out):
    z = gate_c * u
    z = lax.conv_general_dilated(
        z, conv_w.astype(z.dtype), window_strides=(1,), padding=[(CONV_K - 1, 0)],
        dimension_numbers=("NWC", "WIO", "NWC"), feature_group_count=CONV_WIDTH)
    return (gate_b * z) @ w_out


def chunk_causal_attention(q_nope, q_rope, k_nope, k_rope, v):
    B, S, H, _ = q_nope.shape
    n_blk = S // Q_BLOCK
    scale = (QK_NOPE + QK_ROPE) ** -0.5
    k_chunk = jnp.arange(S) // CHUNK

    def to_blocks(t):
        return jnp.moveaxis(t.reshape((B, n_blk, Q_BLOCK) + t.shape[2:]), 1, 0)

    def one_block(args):
        blk, qn, qr = args
        s = (jnp.einsum("bqhd,bkhd->bhqk", qn, k_nope).astype(jnp.float32)
             + jnp.einsum("bqhr,bkr->bhqk", qr, k_rope).astype(jnp.float32)) * scale
        q_chunk = (blk * Q_BLOCK + jnp.arange(Q_BLOCK)) // CHUNK
        mask = k_chunk[None, :] <= q_chunk[:, None]
        s = jnp.where(mask[None, None], s, -jnp.inf)
        p = jax.nn.softmax(s, axis=-1).astype(v.dtype)
        return jnp.einsum("bhqk,bkhd->bqhd", p, v)

    o = lax.map(one_block, (jnp.arange(n_blk), to_blocks(q_nope), to_blocks(q_rope)))
    return jnp.moveaxis(o, 0, 1).reshape(B, S, H, V_DIM)


def mla_mixer(c_q, c_kv_full, cos, sin, g_q, g_kv, w_uq, w_ukv, w_o):
    B, S, _ = c_q.shape
    c_q = rmsnorm(c_q, g_q)
    q = (c_q @ w_uq).reshape(B, S, MLA_HEADS, QK_NOPE + QK_ROPE)
    q_nope = q[..., :QK_NOPE]
    q_rope = apply_rope(q[..., QK_NOPE:], cos[:, :, None, :], sin[:, :, None, :])
    c_kv = rmsnorm(c_kv_full[..., :KV_LORA], g_kv)
    k_rope = apply_rope(c_kv_full[..., KV_LORA:], cos, sin)
    kv = (c_kv @ w_ukv).reshape(B, S, MLA_HEADS, QK_NOPE + V_DIM)
    k_nope = kv[..., :QK_NOPE]
    v = kv[..., QK_NOPE:]
    o = chunk_causal_attention(q_nope, q_rope, k_nope, k_rope, v)
    return o.reshape(B, S, MLA_HEADS * V_DIM) @ w_o


def swiglu(t, w_gate, w_up, w_down):
    return (jax.nn.silu(t @ w_gate) * (t @ w_up)) @ w_down


def moe_swiglu(x, w_router, w_gate, w_up, w_down):
    B, S, D = x.shape
    t = x.reshape(B * S, D)
    logits = (t @ w_router).astype(jnp.float32)
    top_vals, top_idx = lax.top_k(logits, TOP_K)
    top_w = jax.nn.softmax(top_vals, axis=-1)
    gates = jnp.sum(jax.nn.one_hot(top_idx, N_EXPERTS, dtype=jnp.float32) * top_w[..., None], axis=1)
    out = jnp.zeros_like(t)
    for e in range(N_EXPERTS):
        out = out + gates[:, e:e + 1].astype(t.dtype) * swiglu(t, w_gate[e], w_up[e], w_down[e])
    return out.reshape(B, S, D)


def setup_inputs(seed: int = 0) -> dict:
    key = jax.random.key(seed)
    ks = jax.random.split(key, 32)

    def nrm(k, shape, fan_in):
        return jax.random.normal(k, shape, jnp.float32) * (fan_in ** -0.5)

    def gain(k, shape):
        return 1.0 + 0.05 * jax.random.normal(k, shape, jnp.float32)

    x = jax.random.normal(ks[0], (BATCH, SEQ, D_MODEL), jnp.float32)
    offset = jax.random.randint(ks[1], (BATCH,), 0, 64, dtype=jnp.int32) * CHUNK
    positions = offset[:, None] + jnp.arange(SEQ, dtype=jnp.int32)[None, :]
    H = MLA_HEADS
    return {
        "x": x,
        "positions": positions,
        "norm_mix": gain(ks[2], (DEPTH, D_MODEL)),
        "w_in": nrm(ks[3], (DEPTH, D_MODEL, IN_COLS), D_MODEL),
        "b_gate": 0.02 * jax.random.normal(ks[4], (DEPTH, N_BRANCH * D_MODEL), jnp.float32),
        "conv_w": nrm(ks[5], (DEPTH, CONV_K, 1, CONV_WIDTH), CONV_K),
        "w_conv_out": nrm(ks[6], (DEPTH, CONV_WIDTH, D_MODEL), CONV_WIDTH),
        "norm_q": gain(ks[7], (DEPTH, Q_LORA)),
        "norm_kv": gain(ks[8], (DEPTH, KV_LORA)),
        "w_uq": nrm(ks[9], (DEPTH, Q_LORA, H * (QK_NOPE + QK_ROPE)), Q_LORA),
        "w_ukv": nrm(ks[10], (DEPTH, KV_LORA, H * (QK_NOPE + V_DIM)), KV_LORA),
        "w_attn_out": nrm(ks[11], (DEPTH, H * V_DIM, D_MODEL), H * V_DIM),
        "w_mix_out": nrm(ks[12], (DEPTH, D_MODEL, D_MODEL), D_MODEL),
        "norm_ffn": gain(ks[13], (DEPTH, D_MODEL)),
        "dense_w_gate": nrm(ks[14], (N_DENSE, D_MODEL, D_FF_DENSE), D_MODEL),
        "dense_w_up": nrm(ks[15], (N_DENSE, D_MODEL, D_FF_DENSE), D_MODEL),
        "dense_w_down": nrm(ks[16], (N_DENSE, D_FF_DENSE, D_MODEL), D_FF_DENSE),
        "router_w": nrm(ks[17], (N_MOE, D_MODEL, N_EXPERTS), D_MODEL),
        "moe_w_gate": nrm(ks[18], (N_MOE, N_EXPERTS, D_MODEL, D_FF_EXPERT), D_MODEL),
        "moe_w_up": nrm(ks[19], (N_MOE, N_EXPERTS, D_MODEL, D_FF_EXPERT), D_MODEL),
        "moe_w_down": nrm(ks[20], (N_MOE, N_EXPERTS, D_FF_EXPERT, D_MODEL), D_FF_EXPERT),
        "norm_final": gain(ks[21], (D_MODEL,)),
    }


def reference(x, positions, norm_mix, w_in, b_gate, conv_w, w_conv_out, norm_q, norm_kv,
              w_uq, w_ukv, w_attn_out, w_mix_out, norm_ffn, dense_w_gate, dense_w_up,
              dense_w_down, router_w, moe_w_gate, moe_w_up, moe_w_down, norm_final):
    cos, sin = rope_tables(positions)
    split_at = [int(v) for v in np.cumsum(IN_SIZES)[:-1]]
    h = x
    for layer in range(DEPTH):
        xn = rmsnorm(h, norm_mix[layer])
        proj = xn @ w_in[layer]
        gate_b, gate_c, u, c_q, c_kv_full, gate_logits = jnp.split(proj, split_at, axis=-1)
        y_a = short_conv_mixer(gate_b, gate_c, u, conv_w[layer], w_conv_out[layer])
        y_b = mla_mixer(c_q, c_kv_full, cos, sin, norm_q[layer], norm_kv[layer],
                        w_uq[layer], w_ukv[layer], w_attn_out[layer])
        g_a, g_b = jnp.split(jax.nn.sigmoid(gate_logits + b_gate[layer]), N_BRANCH, axis=-1)
        h = h + (g_a * y_a + g_b * y_b) @ w_mix_out[layer]
        xn = rmsnorm(h, norm_ffn[layer])
        i = layer // 2
        if layer % 2 == 0:
            f = swiglu(xn, dense_w_gate[i], dense_w_up[i], dense_w_down[i])
        else:
            f = moe_swiglu(xn, router_w[i], moe_w_gate[i], moe_w_up[i], moe_w_down[i])
        h = h + f
    return rmsnorm(h, norm_final)
```

```cpp
#include <hip/hip_runtime.h>
#include <cstdio>
#include <cstdint>

#ifndef FAST_GEMM_MASK
#define FAST_GEMM_MASK 0x0u
#endif
#ifndef FAST_ATTN
#define FAST_ATTN 0
#endif
enum { GP_PROJ = 0, GP_QUP = 1, GP_KVUP = 2, GP_CONVOUT = 3, GP_ATTNOUT = 4, GP_MIXOUT = 5, GP_FFUP = 6, GP_FFDOWN = 7, GP_MOEUP = 8, GP_MOEDOWN = 9 };
#define FASTG(i) (((FAST_GEMM_MASK) >> (i)) & 1u)

constexpr int M = 16384, D = 1024, SEQ = 2048, NB = 8, NH = 16, QKD = 96, VD = 64, QL = 256, KVL = 128;
constexpr int INC = 5536, NV1 = 5632;
constexpr int FFD = 2816, NE = 8, FFE = 1792;
constexpr int SPMAX = 34816;
constexpr float EPS = 1e-6f;
constexpr float C2 = 0.14724444602590306f;
constexpr int NWAVES = 8;

#define GAS __attribute__((address_space(1)))
#define LAS __attribute__((address_space(3)))
typedef unsigned short bf16_t;
typedef short bf16x8 __attribute__((ext_vector_type(8)));
typedef float f32x4 __attribute__((ext_vector_type(4)));
typedef float f32x2 __attribute__((ext_vector_type(2)));
typedef unsigned u32x4 __attribute__((ext_vector_type(4)));
typedef unsigned u32x2 __attribute__((ext_vector_type(2)));
typedef int i32x2 __attribute__((ext_vector_type(2)));
typedef __bf16 bf16x2_t __attribute__((ext_vector_type(2)));
typedef GAS unsigned gu32;

__device__ __forceinline__ unsigned pk2(float lo, float hi) { f32x2 v = {lo, hi}; bf16x2_t b = __builtin_convertvector(v, bf16x2_t); return __builtin_bit_cast(unsigned, b); }
__device__ __forceinline__ float bflo(unsigned u) { return __uint_as_float(u << 16); }
__device__ __forceinline__ float bfhi(unsigned u) { return __uint_as_float(u & 0xffff0000u); }
__device__ __forceinline__ float bf2f(bf16_t b) { return __uint_as_float((unsigned)b << 16); }
__device__ __forceinline__ u32x4 pack8(const float* v) { u32x4 w; w.x = pk2(v[0], v[1]); w.y = pk2(v[2], v[3]); w.z = pk2(v[4], v[5]); w.w = pk2(v[6], v[7]); return w; }
__device__ __forceinline__ void unpack8(u32x4 w, float* v) { v[0] = bflo(w.x); v[1] = bfhi(w.x); v[2] = bflo(w.y); v[3] = bfhi(w.y); v[4] = bflo(w.z); v[5] = bfhi(w.z); v[6] = bflo(w.w); v[7] = bfhi(w.w); }
__device__ __forceinline__ float sigmoidf_(float x) { return 1.0f / (1.0f + __expf(-x)); }
__device__ __forceinline__ float wave_sum(float v) {
#pragma unroll
    for (int o = 1; o < 64; o <<= 1) v += __shfl_xor(v, o);
    return v;
}
#define LDS_WAIT() asm volatile("s_waitcnt lgkmcnt(0)" ::: "memory")
#define VM_WAIT() asm volatile("s_waitcnt vmcnt(0)" ::: "memory")

constexpr size_t MiB = 1u << 20;
constexpr size_t WS_CTL = 0, CTL_ZERO_BYTES = 64 * 1024;
constexpr size_t WS_COS = 1 * MiB, WS_SIN = 2 * MiB;
constexpr size_t WS_SSQH = 3 * MiB;
constexpr size_t WS_SSQQ = 4 * MiB, WS_SSQKV = WS_SSQQ + 256 * 1024;
constexpr size_t WS_TOPE = WS_SSQKV + 256 * 1024;
constexpr size_t WS_TOPW = WS_TOPE + 128 * 1024;
constexpr size_t WS_RANK = WS_TOPW + 128 * 1024;
constexpr size_t WS_SLOT = WS_RANK + 128 * 1024;
constexpr size_t WS_INVF = WS_SLOT + 128 * 1024;
constexpr size_t WS_WGCNT = WS_INVF + 64 * 1024;
static_assert(WS_WGCNT + 8192 <= 6 * MiB, "small tables");
constexpr size_t WS_HB = 6 * MiB;
constexpr size_t WS_V = WS_HB;
constexpr size_t WS_MW = 38 * MiB, MW_LAYER = 18 * MiB + 512 * 1024;
constexpr size_t MW_WIN = 0, MW_WCO = 11 * MiB, MW_WAO = 13 * MiB, MW_WMX = 15 * MiB, MW_WUQ = 17 * MiB, MW_WUKV = 17 * MiB + 768 * 1024;
constexpr size_t WS_WGU = 75 * MiB, WS_WD = 86 * MiB;
constexpr size_t WS_Z0 = 92 * MiB, WS_GB = 124 * MiB, WS_CQ = 156 * MiB, WS_CKV = 164 * MiB, WS_G = 168 * MiB, WS_Q = 232 * MiB, WS_K = 280 * MiB;
constexpr size_t WS_O = WS_Z0, WS_MX = WS_Q, WS_ACT = 92 * MiB;
constexpr size_t WS_WGUE = 38 * MiB, WS_WDE = 94 * MiB, WS_XP = 122 * MiB, WS_YP = WS_XP, WS_ACTE = 190 * MiB;
constexpr size_t WS_END = 328 * MiB;
static_assert(WS_K + (size_t)M * 1536 * 2 <= WS_END && WS_ACTE + (size_t)SPMAX * FFE * 2 <= WS_END && WS_ACT + (size_t)M * FFD * 2 <= WS_Q, "ws map");
static_assert(WS_WGUE + (size_t)NE * 3584 * 1024 * 2 <= WS_WDE && WS_WDE + (size_t)NE * 1024 * FFE * 2 <= WS_XP && WS_XP + (size_t)SPMAX * 1024 * 2 <= WS_ACTE, "moe map");
constexpr int CW_TMO = 0, CW_BAR = 1024;

constexpr int RING_OFF = 0, RING_BYTES = 131072;
constexpr int LDSCTL_OFF = RING_BYTES, MISC_OFF = LDSCTL_OFF + 320;
constexpr int LDS_BYTES = 147456;

__device__ __forceinline__ int vmap_in(int v) {
    const int t = v >> 8, j = v & 255;
    if (t < 8) return (j < 128) ? (1024 + 128 * t + j) : (2048 + 128 * t + (j - 128));
    if (t < 12) return 256 * (t - 8) + j;
    if (t == 12) return 3072 + j;
    if (t == 13) { if (j < 128) return 3328 + j; if (j < 160) { const int p = (j - 128) >> 1, odd = (j - 128) & 1; return 3456 + p + 16 * odd; } return -1; }
    return 3488 + 256 * (t - 14) + j;
}
__device__ __forceinline__ int vmap_q(int v) { const int h = v / 96, d = v % 96; if (d < 64) return v; const int p = (d - 64) >> 1, odd = (d - 64) & 1; return 96 * h + 64 + p + 16 * odd; }

struct WProj { const float* w; const float* gain; __device__ __forceinline__ float operator()(int k, int v, int) const { const int o = vmap_in(v); return o < 0 ? 0.f : gain[k] * w[(size_t)k * INC + o]; } };
struct WQ { const float* w; const float* gain; __device__ __forceinline__ float operator()(int k, int v, int) const { return gain[k] * w[(size_t)k * 1536 + vmap_q(v)]; } };
struct WKV { const float* w; const float* gain; __device__ __forceinline__ float operator()(int k, int v, int) const { return gain[k] * w[(size_t)k * 2048 + v]; } };
struct WPlain { const float* w; int ldn; size_t estride; __device__ __forceinline__ float operator()(int k, int v, int e) const { return w[(size_t)e * estride + (size_t)k * ldn + v]; } };
struct WGU { const float* wg; const float* wu; const float* gain; int ff; size_t estride;
    __device__ __forceinline__ float operator()(int k, int v, int e) const { const int t = v >> 8, j = v & 255; const size_t o = (size_t)e * estride + (size_t)k * ff + 128 * t + (j & 127);
        const size_t delta = (size_t)((const char*)wu - (const char*)wg);
        const float* p = (const float*)((const char*)wg + ((j >= 128) ? delta : (size_t)0)); return gain[k] * p[o]; } };

namespace pg8 {
constexpr int BM = 256, BK = 64, HALF = 128, HTB = HALF * BK * 2, STAGE_BYTES = 8 * HTB, NXCD = 8, WGM = 8;
__device__ __forceinline__ int lds_byte(int r, int c) { const int st = (r >> 4) * 2 + (c >> 5), rr = r & 15, cc = c & 31, ob = rr * 64 + cc * 2; return st * 1024 + (ob ^ (((ob >> 9) & 1) << 5)); }
__device__ __forceinline__ void stage_rc(int b, int& R, int& C) { const int st = b / 1024, sb = b % 1024, swz = sb ^ (((sb >> 9) & 1) << 5); R = (st >> 1) * 16 + swz / 64; C = (st & 1) * 32 + (swz % 64) / 2; }
__device__ __forceinline__ int perm32(int rho) { const int n = rho >> 4, i = rho & 15; return 8 * (i >> 2) + 4 * n + (i & 3); }

struct Unit { int pm, pn, e; };
struct Gemm { const bf16_t* A; const bf16_t* Bt; int K; size_t estride; };

struct StaticOrder {
    int nM, nN, nwg, G, c; const volatile LAS unsigned* ebt;
    __device__ void init(int nM_, int nN_, int G_, int c_, const volatile LAS unsigned* ebt_ = nullptr) { nM = nM_; nN = nN_; nwg = nM * nN; G = G_; c = c_; ebt = ebt_; }
    __device__ bool next(int i, Unit& u) const {
        const long L = (long)i * G + c; if (L >= nwg) return false;
        int wgid = (int)L; { const int q = nwg / NXCD, r = nwg % NXCD, xcd = wgid % NXCD, off = wgid / NXCD; wgid = (xcd < r ? xcd * (q + 1) : r * (q + 1) + (xcd - r) * q) + off; }
        const int nig = WGM * nN, gid = wgid / nig, fm = gid * WGM, gsz = (nM - fm) < WGM ? (nM - fm) : WGM;
        u.pm = fm + ((wgid % nig) % gsz); u.pn = (wgid % nig) / gsz; u.e = 0;
        if (ebt) { int e = 0;
#pragma unroll
            for (int j = 1; j < NE; ++j) e += ((int)ebt[j] <= u.pm) ? 1 : 0;
            u.e = e; }
        return true;
    }
};
}
using pg8::Unit;
typedef f32x4 Acc[2][2][4][2];

#define EPI_ROW(ai, m) (u.pm * 256 + (ai) * 128 + wr * 64 + (m) * 16 + fr)
#define EPI_GET8(dst, ai, bj, m, sc) do { const f32x4 _a = acc[ai][bj][m][0], _b = acc[ai][bj][m][1]; dst[0] = _a[0] * (sc); dst[1] = _a[1] * (sc); dst[2] = _a[2] * (sc); dst[3] = _a[3] * (sc); \
        dst[4] = _b[0] * (sc); dst[5] = _b[1] * (sc); dst[6] = _b[2] * (sc); dst[7] = _b[3] * (sc); } while (0)
__device__ __forceinline__ float sum16(const float* p) { const f32x4 a = *(const f32x4*)p, b = *(const f32x4*)(p + 4), c = *(const f32x4*)(p + 8), d = *(const f32x4*)(p + 12);
    return ((a[0] + a[1]) + (a[2] + a[3])) + ((b[0] + b[1]) + (b[2] + b[3])) + ((c[0] + c[1]) + (c[2] + c[3])) + ((d[0] + d[1]) + (d[2] + d[3])); }
__device__ __forceinline__ float sum4(const float* p) { const f32x4 a = *(const f32x4*)p; return (a[0] + a[1]) + (a[2] + a[3]); }
__device__ __forceinline__ float sumsq8(const float* v) { return ((v[0] * v[0] + v[1] * v[1]) + (v[2] * v[2] + v[3] * v[3])) + ((v[4] * v[4] + v[5] * v[5]) + (v[6] * v[6] + v[7] * v[7])); }

struct EpiProj {
    static constexpr bool PERM = true;
    unsigned char* ws; const float* bgate;
    __device__ __forceinline__ void operator()(const Acc& acc, const Unit& u, int wr, int wc, int fr, int fq) const {
        const int cb = wc * 32 + 8 * fq, pn = u.pn;
        const float* ssqh = (const float*)(ws + WS_SSQH);
#define PROJ_ROWS_BEGIN _Pragma("unroll") for (int ai = 0; ai < 2; ++ai) _Pragma("unroll") for (int m = 0; m < 4; ++m) { const int row = EPI_ROW(ai, m); \
            const float inv = rsqrtf(sum16(ssqh + (size_t)row * 16) * (1.0f / D) + EPS); float v0[8], v1[8]; EPI_GET8(v0, ai, 0, m, inv); EPI_GET8(v1, ai, 1, m, inv);
#define PROJ_ROWS_END }
        if (pn < 8) {
            bf16_t* z0 = (bf16_t*)(ws + WS_Z0);
            PROJ_ROWS_BEGIN
                float z[8];
#pragma unroll
                for (int i = 0; i < 8; ++i) z[i] = v0[i] * v1[i];
                *(u32x4*)(z0 + (size_t)row * 1024 + 128 * pn + cb) = pack8(z);
            PROJ_ROWS_END
        } else if (pn < 12) {
            bf16_t* gb = (bf16_t*)(ws + WS_GB);
            PROJ_ROWS_BEGIN
                bf16_t* p = gb + (size_t)row * 1024 + 256 * (pn - 8) + cb;
                *(u32x4*)p = pack8(v0); *(u32x4*)(p + 128) = pack8(v1);
            PROJ_ROWS_END
        } else if (pn == 12) {
            bf16_t* cq = (bf16_t*)(ws + WS_CQ); float* ssqq = (float*)(ws + WS_SSQQ);
            PROJ_ROWS_BEGIN
                bf16_t* p = cq + (size_t)row * 256 + cb;
                *(u32x4*)p = pack8(v0); *(u32x4*)(p + 128) = pack8(v1);
                float s = sumsq8(v0) + sumsq8(v1); s += __shfl_xor(s, 16); s += __shfl_xor(s, 32);
                if (fq == 0) ssqq[(size_t)row * 4 + wc] = s;
            PROJ_ROWS_END
        } else if (pn == 13) {
            bf16_t* ckv = (bf16_t*)(ws + WS_CKV); float* ssqkv = (float*)(ws + WS_SSQKV); bf16_t* kk = (bf16_t*)(ws + WS_K);
            const float* cs = (const float*)(ws + WS_COS); const float* sn = (const float*)(ws + WS_SIN);
            PROJ_ROWS_BEGIN
                *(u32x4*)(ckv + (size_t)row * 128 + cb) = pack8(v0);
                float s = sumsq8(v0); s += __shfl_xor(s, 16); s += __shfl_xor(s, 32);
                if (fq == 0) ssqkv[(size_t)row * 4 + wc] = s;
                if (wc == 0) {
                    const f32x4 c4 = *(const f32x4*)(cs + (size_t)row * 16 + 4 * fq), s4 = *(const f32x4*)(sn + (size_t)row * 16 + 4 * fq);
                    float r[8];
#pragma unroll
                    for (int j = 0; j < 4; ++j) { const float t1 = v1[2 * j], t2 = v1[2 * j + 1]; r[2 * j] = t1 * c4[j] - t2 * s4[j]; r[2 * j + 1] = t1 * s4[j] + t2 * c4[j]; }
                    const u32x4 w = pack8(r);
                    bf16_t* kp = kk + (size_t)row * 1536 + 64 + 8 * fq;
#pragma unroll
                    for (int h = 0; h < NH; ++h) *(u32x4*)(kp + 96 * h) = w;
                }
            PROJ_ROWS_END
        } else {
            bf16_t* g = (bf16_t*)(ws + WS_G);
            const int c = 256 * (pn - 14) + cb;
            const f32x4 b0 = *(const f32x4*)(bgate + c), b1 = *(const f32x4*)(bgate + c + 4), b2 = *(const f32x4*)(bgate + c + 128), b3 = *(const f32x4*)(bgate + c + 132);
            PROJ_ROWS_BEGIN
                float g0[8], g1[8];
#pragma unroll
                for (int i = 0; i < 4; ++i) { g0[i] = sigmoidf_(v0[i] + b0[i]); g0[4 + i] = sigmoidf_(v0[4 + i] + b1[i]); g1[i] = sigmoidf_(v1[i] + b2[i]); g1[4 + i] = sigmoidf_(v1[4 + i] + b3[i]); }
                bf16_t* p = g + (size_t)row * 2048 + c;
                *(u32x4*)p = pack8(g0); *(u32x4*)(p + 128) = pack8(g1);
            PROJ_ROWS_END
        }
#undef PROJ_ROWS_BEGIN
#undef PROJ_ROWS_END
    }
};

struct EpiQ {
    static constexpr bool PERM = true;
    unsigned char* ws;
    __device__ __forceinline__ void operator()(const Acc& acc, const Unit& u, int wr, int wc, int fr, int fq) const {
        const float* ssqq = (const float*)(ws + WS_SSQQ); const float* cs = (const float*)(ws + WS_COS); const float* sn = (const float*)(ws + WS_SIN); bf16_t* q = (bf16_t*)(ws + WS_Q);
#pragma unroll
        for (int ai = 0; ai < 2; ++ai)
#pragma unroll
            for (int m = 0; m < 4; ++m) {
                const int row = EPI_ROW(ai, m);
                const float inv = rsqrtf(sum4(ssqq + (size_t)row * 4) * (1.0f / QL) + EPS) * C2;
#pragma unroll
                for (int bj = 0; bj < 2; ++bj) {
                    float v[8]; EPI_GET8(v, ai, bj, m, inv);
                    const int c = u.pn * 256 + bj * 128 + wc * 32 + 8 * fq, d = c % 96;
                    if (d >= 64) { const int p0 = (d - 64) >> 1;
                        const f32x4 c4 = *(const f32x4*)(cs + (size_t)row * 16 + p0), s4 = *(const f32x4*)(sn + (size_t)row * 16 + p0);
#pragma unroll
                        for (int j = 0; j < 4; ++j) { const float t1 = v[2 * j], t2 = v[2 * j + 1]; v[2 * j] = t1 * c4[j] - t2 * s4[j]; v[2 * j + 1] = t1 * s4[j] + t2 * c4[j]; } }
                    *(u32x4*)(q + (size_t)row * 1536 + c) = pack8(v);
                }
            }
    }
};
struct EpiKV {
    static constexpr bool PERM = true;
    unsigned char* ws;
    __device__ __forceinline__ void operator()(const Acc& acc, const Unit& u, int wr, int wc, int fr, int fq) const {
        const float* ssqkv = (const float*)(ws + WS_SSQKV); bf16_t* kk = (bf16_t*)(ws + WS_K); bf16_t* vv = (bf16_t*)(ws + WS_V);
#pragma unroll
        for (int ai = 0; ai < 2; ++ai)
#pragma unroll
            for (int m = 0; m < 4; ++m) {
                const int row = EPI_ROW(ai, m);
                const float inv = rsqrtf(sum4(ssqkv + (size_t)row * 4) * (1.0f / KVL) + EPS);
#pragma unroll
                for (int bj = 0; bj < 2; ++bj) {
                    float v[8]; EPI_GET8(v, ai, bj, m, inv);
                    const int c = u.pn * 256 + bj * 128 + wc * 32 + 8 * fq, h = c >> 7, j = c & 127;
                    if (j < 64) *(u32x4*)(kk + (size_t)row * 1536 + 96 * h + j) = pack8(v);
                    else *(u32x4*)(vv + (size_t)row * 1024 + 64 * h + (j - 64)) = pack8(v);
                }
            }
    }
};
template <int MODE> struct EpiGate {
    static constexpr bool PERM = true;
    unsigned char* ws;
    __device__ __forceinline__ void operator()(const Acc& acc, const Unit& u, int wr, int wc, int fr, int fq) const {
        const bf16_t* g = (const bf16_t*)(ws + WS_G); bf16_t* mx = (bf16_t*)(ws + WS_MX);
#pragma unroll
        for (int ai = 0; ai < 2; ++ai)
#pragma unroll
            for (int m = 0; m < 4; ++m) {
                const int row = EPI_ROW(ai, m);
#pragma unroll
                for (int bj = 0; bj < 2; ++bj) {
                    float v[8]; EPI_GET8(v, ai, bj, m, 1.0f);
                    const int c = u.pn * 256 + bj * 128 + wc * 32 + 8 * fq;
                    float gg[8]; unpack8(*(const u32x4*)(g + (size_t)row * 2048 + MODE * 1024 + c), gg);
                    bf16_t* p = mx + (size_t)row * 1024 + c;
                    if (MODE == 1) { float o[8]; unpack8(*(const u32x4*)p, o);
#pragma unroll
                        for (int i = 0; i < 8; ++i) v[i] = o[i] + gg[i] * v[i]; }
                    else {
#pragma unroll
                        for (int i = 0; i < 8; ++i) v[i] = gg[i] * v[i]; }
                    *(u32x4*)p = pack8(v);
                }
            }
    }
};
struct EpiResid {
    static constexpr bool PERM = true;
    const float* hin; float* h; unsigned char* ws;
    __device__ __forceinline__ void operator()(const Acc& acc, const Unit& u, int wr, int wc, int fr, int fq) const {
        bf16_t* hb = (bf16_t*)(ws + WS_HB); float* ssqh = (float*)(ws + WS_SSQH);
#pragma unroll
        for (int ai = 0; ai < 2; ++ai)
#pragma unroll
            for (int m = 0; m < 4; ++m) {
                const int row = EPI_ROW(ai, m); float s = 0.f;
#pragma unroll
                for (int bj = 0; bj < 2; ++bj) {
                    float v[8]; EPI_GET8(v, ai, bj, m, 1.0f);
                    const size_t o = (size_t)row * 1024 + u.pn * 256 + bj * 128 + wc * 32 + 8 * fq;
                    const f32x4 r0 = *(const f32x4*)(hin + o), r1 = *(const f32x4*)(hin + o + 4);
#pragma unroll
                    for (int i = 0; i < 4; ++i) { v[i] += r0[i]; v[4 + i] += r1[i]; }
                    *(f32x4*)(h + o) = (f32x4){v[0], v[1], v[2], v[3]}; *(f32x4*)(h + o + 4) = (f32x4){v[4], v[5], v[6], v[7]};
                    *(u32x4*)(hb + o) = pack8(v);
                    s += sumsq8(v);
                }
                s += __shfl_xor(s, 16); s += __shfl_xor(s, 32);
                if (fq == 0) ssqh[(size_t)row * 16 + 4 * u.pn + wc] = s;
            }
    }
};
struct EpiSwiglu {
    static constexpr bool PERM = true;
    const float* ssqh; bf16_t* act; int ldc;
    __device__ __forceinline__ void operator()(const Acc& acc, const Unit& u, int wr, int wc, int fr, int fq) const {
#pragma unroll
        for (int ai = 0; ai < 2; ++ai)
#pragma unroll
            for (int m = 0; m < 4; ++m) {
                const int row = EPI_ROW(ai, m);
                const float inv = ssqh ? rsqrtf(sum16(ssqh + (size_t)row * 16) * (1.0f / D) + EPS) : 1.0f;
                float v0[8], v1[8]; EPI_GET8(v0, ai, 0, m, inv); EPI_GET8(v1, ai, 1, m, inv);
#pragma unroll
                for (int i = 0; i < 8; ++i) v0[i] = v0[i] * sigmoidf_(v0[i]) * v1[i];
                *(u32x4*)(act + (size_t)row * ldc + 128 * u.pn + wc * 32 + 8 * fq) = pack8(v0);
            }
    }
};
struct EpiStore {
    static constexpr bool PERM = true;
    bf16_t* o; int ldc;
    __device__ __forceinline__ void operator()(const Acc& acc, const Unit& u, int wr, int wc, int fr, int fq) const {
#pragma unroll
        for (int ai = 0; ai < 2; ++ai)
#pragma unroll
            for (int m = 0; m < 4; ++m) {
                const int row = EPI_ROW(ai, m);
#pragma unroll
                for (int bj = 0; bj < 2; ++bj) { float v[8]; EPI_GET8(v, ai, bj, m, 1.0f);
                    *(u32x4*)(o + (size_t)row * ldc + u.pn * 256 + bj * 128 + wc * 32 + 8 * fq) = pack8(v); }
            }
    }
};

template <class Epi, class WF>
__device__ __forceinline__ void naive_gemm_phase(LAS unsigned char* lds, const bf16_t* A, int K, const pg8::StaticOrder& S, const Epi& E, const WF& wf) {
    int tid_ = threadIdx.x; asm volatile("" : "+v"(tid_));
    const int tid = tid_, wid = tid >> 6, lane = tid & 63, wr = wid >> 2, wc = wid & 3, fr = lane & 15, fq = lane >> 4;
    LAS float* As = (LAS float*)lds;
    LAS float* Ws = As + 16 * 256;
    const int ar = tid >> 1, ak = (tid & 1) * 8, wk = tid >> 5, wcg = (tid & 31) * 8;
    Unit u;
    for (int ui = 0; S.next(ui, u); ++ui) {
        Acc acc;
#pragma unroll
        for (int a = 0; a < 2; ++a)
#pragma unroll
            for (int b = 0; b < 2; ++b)
#pragma unroll
                for (int m = 0; m < 4; ++m)
#pragma unroll
                    for (int n = 0; n < 2; ++n) acc[a][b][m][n] = (f32x4){0.f, 0.f, 0.f, 0.f};
        const bf16_t* arow = A + (size_t)(u.pm * 256 + ar) * K + ak;
#pragma unroll 1
        for (int k0 = 0; k0 < K; k0 += 16) {
            { float af[8]; unpack8(*(const u32x4*)(arow + k0), af);
#pragma unroll
              for (int i = 0; i < 8; ++i) As[(ak + i) * 256 + ar] = af[i];
#pragma unroll
              for (int i = 0; i < 8; ++i) Ws[wk * 256 + wcg + i] = wf(k0 + wk, u.pn * 256 + wcg + i, u.e); }
            LDS_WAIT(); __syncthreads();
#pragma unroll 2
            for (int kk = 0; kk < 16; ++kk) {
                float a[2][4], w[2][8];
#pragma unroll
                for (int ai = 0; ai < 2; ++ai)
#pragma unroll
                    for (int m = 0; m < 4; ++m) a[ai][m] = As[kk * 256 + ai * 128 + wr * 64 + m * 16 + fr];
#pragma unroll
                for (int bj = 0; bj < 2; ++bj)
#pragma unroll
                    for (int i = 0; i < 8; ++i) w[bj][i] = Ws[kk * 256 + bj * 128 + wc * 32 + 8 * fq + i];
#pragma unroll
                for (int ai = 0; ai < 2; ++ai)
#pragma unroll
                    for (int bj = 0; bj < 2; ++bj)
#pragma unroll
                        for (int m = 0; m < 4; ++m)
#pragma unroll
                            for (int n = 0; n < 2; ++n)
#pragma unroll
                                for (int j = 0; j < 4; ++j) acc[ai][bj][m][n][j] += a[ai][m] * w[bj][4 * n + j];
            }
            LDS_WAIT(); __syncthreads();
        }
        E(acc, u, wr, wc, fr, fq);
    }
}

#define XB_TMO      128
#define XB_XCNT(j)  (256  + 64 * (j))
#define XB_XSUB(j)  (1280 + 64 * (j))
#define XB_XGEN(j)  (2304 + 64 * (j))
#define XB_TOP      3328
#define XB_TOPGEN   3392
#define XCD_BAR_WORDS 3456
#define XB_SPIN_CAP (1u << 22)
__device__ __forceinline__ unsigned xb_ld(unsigned* p)              { return __hip_atomic_load(p, __ATOMIC_RELAXED, __HIP_MEMORY_SCOPE_AGENT); }
__device__ __forceinline__ unsigned xb_add(unsigned* p, unsigned v) { return __hip_atomic_fetch_add(p, v, __ATOMIC_RELAXED, __HIP_MEMORY_SCOPE_AGENT); }
__device__ __forceinline__ unsigned xb_xcc_id() { return (unsigned)__builtin_amdgcn_s_getreg((3 << 11) | 20) & 0xFu; }
#define XB_SPIN(cond, bar) do { unsigned _sp = 0; while (cond) { __builtin_amdgcn_s_sleep(1); \
    if ((++_sp & 255u) == 0u) { if (xb_ld(&(bar)[XB_TMO])) break; if (_sp > XB_SPIN_CAP) { atomicAdd(&(bar)[XB_TMO], 1u); break; } } } } while (0)
struct XcdBarrier { unsigned* bar; unsigned x; volatile LAS unsigned* st; };
__device__ __forceinline__ XcdBarrier xcd_barrier_post(unsigned* bar, volatile LAS unsigned* st) {
    XcdBarrier b; b.bar = bar; b.x = xb_xcc_id(); b.st = st;
    if (threadIdx.x == 0) (void)xb_add(&bar[XB_XCNT(b.x)], 1u);
    return b;
}
__device__ __forceinline__ void xcd_barrier_complete(unsigned* bar, unsigned x, unsigned& nloc, unsigned& nx) {
    const unsigned G = gridDim.x * gridDim.y * gridDim.z;
    unsigned sum, cnt, mine, sp = 0u;
    for (;;) {
        sum = 0u; cnt = 0u; mine = 0u;
#pragma unroll
        for (unsigned j = 0; j < 16; ++j) { const unsigned c = xb_ld(&bar[XB_XCNT(j)]); sum += c; cnt += (c > 0u) ? 1u : 0u; mine = (j == x) ? c : mine; }
        if (sum == G) break;
        __builtin_amdgcn_s_sleep(1);
        if ((++sp & 255u) == 0u) { if (xb_ld(&bar[XB_TMO])) break; if (sp > XB_SPIN_CAP) { atomicAdd(&bar[XB_TMO], 1u); break; } }
    }
    nloc = mine > 0u ? mine : 1u; nx = cnt > 0u ? cnt : 1u;
}
__device__ __forceinline__ void xcd_barrier(const XcdBarrier& b) {
    asm volatile("s_waitcnt vmcnt(0)" ::: "memory");
    __syncthreads();
    if (threadIdx.x == 0) {
        unsigned* bar = b.bar;
        __builtin_amdgcn_s_waitcnt(0);
        unsigned nloc = b.st[0], nx = b.st[1];
        if (nloc == 0u) { xcd_barrier_complete(bar, b.x, nloc, nx); b.st[0] = nloc; b.st[1] = nx; }
        const unsigned old = xb_add(&bar[XB_XSUB(b.x)], 1u);
        const unsigned gen = old / nloc;
        if (old + 1u == (gen + 1u) * nloc) {
            __builtin_amdgcn_fence(__ATOMIC_RELEASE, "agent");
            asm volatile("s_waitcnt vmcnt(0)" ::: "memory");
            const unsigned og = xb_add(&bar[XB_TOP], 1u);
            const unsigned tg = og / nx;
            if (og + 1u == (tg + 1u) * nx) xb_add(&bar[XB_TOPGEN], 1u);
            else XB_SPIN(xb_ld(&bar[XB_TOPGEN]) == tg, bar);
            __builtin_amdgcn_fence(__ATOMIC_ACQUIRE, "agent");
            xb_add(&bar[XB_XGEN(b.x)], 1u);
            asm volatile("s_waitcnt vmcnt(0)" ::: "memory");
        } else {
            XB_SPIN(xb_ld(&bar[XB_XGEN(b.x)]) == gen, bar);
            __builtin_amdgcn_fence(__ATOMIC_ACQUIRE, "agent");
            asm volatile("s_waitcnt vmcnt(0)" ::: "memory");
        }
    }
    __syncthreads();
}

struct Args { const float* in[22]; float* out; unsigned char* ws; };
struct Frame {
    LAS unsigned char* lds; volatile LAS unsigned* MISC;
    int tid, lane, wave, vcu, G;
};

__device__ __forceinline__ void p0_rows(Frame& F_, unsigned char* ws, const float* x, const int* pos) {
    Frame F = F_; asm volatile("" : "+v"(F.lane), "+v"(F.tid));
    const int gw = F.vcu * NWAVES + F.wave, NGW = F.G * NWAVES;
    bf16_t* hb = (bf16_t*)(ws + WS_HB); float* ssqh = (float*)(ws + WS_SSQH);
    for (int r = gw; r < M; r += NGW) {
        const f32x4* xr = (const f32x4*)(x + (size_t)r * D) + F.lane; f32x4 v[4]; float s = 0.f;
#pragma unroll
        for (int j = 0; j < 4; ++j) { v[j] = xr[64 * j]; s += (v[j][0] * v[j][0] + v[j][1] * v[j][1]) + (v[j][2] * v[j][2] + v[j][3] * v[j][3]); }
        s = wave_sum(s);
        u32x2* o = (u32x2*)(hb + (size_t)r * D) + F.lane;
#pragma unroll
        for (int j = 0; j < 4; ++j) { u32x2 w; w.x = pk2(v[j][0], v[j][1]); w.y = pk2(v[j][2], v[j][3]); o[64 * j] = w; }
        if (F.lane < 16) ssqh[(size_t)r * 16 + F.lane] = (F.lane == 0) ? s : 0.f;
    }
    float* cs = (float*)(ws + WS_COS); float* sn = (float*)(ws + WS_SIN);
    const double invf[16] = {1.0, 0.5623413251903491, 0.31622776601683794, 0.1778279410038923, 0.1, 0.05623413251903491, 0.03162277660168379, 0.01778279410038923,
                             0.01, 0.005623413251903491, 0.0031622776601683794, 0.0017782794100389228, 0.001, 0.0005623413251903491, 0.00031622776601683794, 0.00017782794100389227};
    for (int idx = (F.vcu * NWAVES + F.wave) * 64 + F.lane; idx < M * 16; idx += NGW * 64) {
        const int r = idx >> 4, i = idx & 15;
        double f = invf[0];
#pragma unroll
        for (int j = 1; j < 16; ++j) f = (i == j) ? invf[j] : f;
        const float angf = (float)pos[r] * (float)f;
        const double a = (double)angf;
        const double n = __builtin_rint(a * 0.6366197723675814);
        const double rr = (a - n * 1.5707963267948966) - n * 6.123233995736766e-17;
        const double r2 = rr * rr;
        const double sp = rr * (1.0 + r2 * (-1.0 / 6 + r2 * (1.0 / 120 + r2 * (-1.0 / 5040 + r2 * (1.0 / 362880 + r2 * (-1.0 / 39916800 + r2 * (1.0 / 6227020800.0)))))));
        const double cp = 1.0 + r2 * (-0.5 + r2 * (1.0 / 24 + r2 * (-1.0 / 720 + r2 * (1.0 / 40320 + r2 * (-1.0 / 3628800 + r2 * (1.0 / 479001600.0))))));
        const int q = ((int)n) & 3;
        const double sv = (q == 0) ? sp : (q == 1) ? cp : (q == 2) ? -sp : -cp;
        const double cv = (q == 0) ? cp : (q == 1) ? -sp : (q == 2) ? -cp : sp;
        cs[idx] = (float)cv; sn[idx] = (float)sv;
    }
}

template <class WF>
__device__ __forceinline__ void prep_item(const WF& wf, int K, int N, int e, bf16_t* Bt, LAS float* scr, int item, int lane) {
    const int nblk = N / 32, kb = item / nblk, nb = item % nblk, k0 = 64 * kb, n0 = 32 * nb;
#pragma unroll 8
    for (int i = 0; i < 32; ++i) { const int kk = 2 * i + (lane >> 5); scr[kk * 33 + (lane & 31)] = wf(k0 + kk, n0 + (lane & 31), e); }
    LDS_WAIT(); asm volatile("" ::: "memory");
    const int c = lane & 7;
#pragma unroll
    for (int j = 0; j < 4; ++j) { const int n = (lane >> 3) + 8 * j; const LAS float* s = scr + (8 * c) * 33 + n;
        u32x4 o; o.x = pk2(s[0 * 33], s[1 * 33]); o.y = pk2(s[2 * 33], s[3 * 33]); o.z = pk2(s[4 * 33], s[5 * 33]); o.w = pk2(s[6 * 33], s[7 * 33]);
        *(u32x4*)(Bt + (size_t)(n0 + n) * K + k0 + 8 * c) = o; }
    LDS_WAIT(); asm volatile("" ::: "memory");
}
template <class WF>
__device__ __forceinline__ void prep_weight(Frame& F, const WF& wf, int K, int N, int ne, bf16_t* Bt, size_t estride, int& itbase) {
    LAS float* scr = (LAS float*)(F.lds + RING_OFF + F.wave * 16384);
    const int gw = F.vcu * NWAVES + F.wave, NGW = F.G * NWAVES;
    const int per = (K / 64) * (N / 32), n = per * ne;
    int first = (gw - (itbase % NGW) + NGW) % NGW;
    for (int it = first; it < n; it += NGW) { const int e = it / per; prep_item(wf, K, N, e, Bt + (size_t)e * estride, scr, it % per, F.lane); }
    itbase += n;
}

__device__ __forceinline__ void conv_pass(Frame& F_, unsigned char* ws, const float* cw) {
    Frame F = F_; asm volatile("" : "+v"(F.lane), "+v"(F.tid));
    const int gw = F.vcu * NWAVES + F.wave, NGW = F.G * NWAVES;
    const bf16_t* z0 = (const bf16_t*)(ws + WS_Z0); bf16_t* gb = (bf16_t*)(ws + WS_GB);
    for (int it = gw; it < (M / 8) * 2; it += NGW) {
        const int t0 = (it >> 1) * 8, c0 = (it & 1) * 512 + F.lane * 8;
        float w0[8], w1[8], w2[8];
#pragma unroll
        for (int i = 0; i < 8; ++i) { w0[i] = cw[c0 + i]; w1[i] = cw[1024 + c0 + i]; w2[i] = cw[2048 + c0 + i]; }
        float zm2[8], zm1[8];
        if ((t0 % SEQ) != 0) { unpack8(*(const u32x4*)(z0 + (size_t)(t0 - 2) * 1024 + c0), zm2); unpack8(*(const u32x4*)(z0 + (size_t)(t0 - 1) * 1024 + c0), zm1); }
        else {
#pragma unroll
            for (int i = 0; i < 8; ++i) { zm2[i] = 0.f; zm1[i] = 0.f; } }
#pragma unroll
        for (int r = 0; r < 8; ++r) {
            float z[8], g[8], o[8]; unpack8(*(const u32x4*)(z0 + (size_t)(t0 + r) * 1024 + c0), z); unpack8(*(const u32x4*)(gb + (size_t)(t0 + r) * 1024 + c0), g);
#pragma unroll
            for (int i = 0; i < 8; ++i) { o[i] = g[i] * (w0[i] * zm2[i] + w1[i] * zm1[i] + w2[i] * z[i]); zm2[i] = zm1[i]; zm1[i] = z[i]; }
            *(u32x4*)(gb + (size_t)(t0 + r) * 1024 + c0) = pack8(o);
        }
    }
}

__device__ __forceinline__ void naive_attention(Frame& F_, unsigned char* ws) {
    Frame F = F_; asm volatile("" : "+v"(F.lane), "+v"(F.tid));
    const int gw = F.vcu * NWAVES + F.wave, NGW = F.G * NWAVES;
    const bf16_t* Q = (const bf16_t*)(ws + WS_Q); const bf16_t* K = (const bf16_t*)(ws + WS_K); const bf16_t* V = (const bf16_t*)(ws + WS_V); bf16_t* O = (bf16_t*)(ws + WS_O);
    for (int it = gw; it < NB * NH * 32; it += NGW) {
        const int ck = 31 - (it / (NB * NH)), bh = it % (NB * NH), b = bh / NH, h = bh % NH;
        const size_t row = (size_t)b * SEQ + ck * 64 + F.lane;
        float q[96];
#pragma unroll
        for (int j = 0; j < 12; ++j) unpack8(*(const u32x4*)(Q + row * 1536 + 96 * h + 8 * j), q + 8 * j);
        float o[64];
#pragma unroll
        for (int i = 0; i < 64; ++i) o[i] = 0.f;
        float mx = -INFINITY, l = 0.f;
        const int nk = (ck + 1) * 64;
        for (int j = 0; j < nk; ++j) {
            const size_t kr = (size_t)b * SEQ + j;
            float s = 0.f;
#pragma unroll
            for (int c = 0; c < 12; ++c) { float kf[8]; unpack8(*(const u32x4*)(K + kr * 1536 + 96 * h + 8 * c), kf);
#pragma unroll
                for (int i = 0; i < 8; ++i) s += q[8 * c + i] * kf[i]; }
            const float mn = fmaxf(mx, s), corr = exp2f(mx - mn), p = exp2f(s - mn);
            l = l * corr + p; mx = mn;
#pragma unroll
            for (int c = 0; c < 8; ++c) { float vf[8]; unpack8(*(const u32x4*)(V + kr * 1024 + 64 * h + 8 * c), vf);
#pragma unroll
                for (int i = 0; i < 8; ++i) o[8 * c + i] = o[8 * c + i] * corr + p * vf[i]; }
        }
        const float rl = 1.0f / l;
#pragma unroll
        for (int c = 0; c < 8; ++c) { float t[8];
#pragma unroll
            for (int i = 0; i < 8; ++i) t[i] = o[8 * c + i] * rl;
            *(u32x4*)(O + row * 1024 + 64 * h + 8 * c) = pack8(t); }
    }
}

__device__ __forceinline__ void route_pass1(Frame& F_, unsigned char* ws, const float* H, const float* gain, const float* rw) {
    Frame F = F_; asm volatile("" : "+v"(F.lane), "+v"(F.tid));
    const int wg = blockIdx.x, t0 = wg * 64;
    LAS int* se = (LAS int*)(F.lds + RING_OFF);
    LAS int* rk = se + 128;
    float* invf = (float*)(ws + WS_INVF); float* topw = (float*)(ws + WS_TOPW);
    for (int i = 0; i < 8; ++i) {
        const int tl = F.wave * 8 + i, t = t0 + tl;
        const f32x4* hr = (const f32x4*)(H + (size_t)t * D) + F.lane; f32x4 v[4]; float s = 0.f;
#pragma unroll
        for (int j = 0; j < 4; ++j) { v[j] = hr[64 * j]; s += (v[j][0] * v[j][0] + v[j][1] * v[j][1]) + (v[j][2] * v[j][2] + v[j][3] * v[j][3]); }
        s = wave_sum(s);
        const float inv = rsqrtf(s * (1.0f / D) + EPS);
        float lg[8];
#pragma unroll
        for (int e = 0; e < 8; ++e) lg[e] = 0.f;
#pragma unroll
        for (int j = 0; j < 4; ++j) {
            const int k = 4 * (F.lane + 64 * j);
            const f32x4 g4 = *(const f32x4*)(gain + k);
#pragma unroll
            for (int c = 0; c < 4; ++c) { const float xn = (v[j][c] * inv) * g4[c];
                const f32x4 r0 = *(const f32x4*)(rw + (size_t)(k + c) * 8), r1 = *(const f32x4*)(rw + (size_t)(k + c) * 8 + 4);
                lg[0] += xn * r0[0]; lg[1] += xn * r0[1]; lg[2] += xn * r0[2]; lg[3] += xn * r0[3]; lg[4] += xn * r1[0]; lg[5] += xn * r1[1]; lg[6] += xn * r1[2]; lg[7] += xn * r1[3]; }
        }
#pragma unroll
        for (int e = 0; e < 8; ++e) lg[e] = wave_sum(lg[e]);
        if (F.lane == 0) {
            int e0 = 0; float b0 = lg[0];
#pragma unroll
            for (int e = 1; e < 8; ++e) if (lg[e] > b0) { b0 = lg[e]; e0 = e; }
            int e1 = -1; float b1 = -INFINITY;
#pragma unroll
            for (int e = 0; e < 8; ++e) if (e != e0 && lg[e] > b1) { b1 = lg[e]; e1 = e; }
            const float w1 = 1.0f / (1.0f + __expf(b0 - b1)), w0 = 1.0f - w1;
            se[2 * tl] = e0; se[2 * tl + 1] = e1;
            invf[t] = inv; topw[2 * t] = w0; topw[2 * t + 1] = w1;
        }
    }
    LDS_WAIT(); __syncthreads();
    if (F.tid < NE) { int cnt = 0;
        for (int tl = 0; tl < 64; ++tl) { if (se[2 * tl] == F.tid) rk[2 * tl] = cnt++; if (se[2 * tl + 1] == F.tid) rk[2 * tl + 1] = cnt++; }
        ((int*)(ws + WS_WGCNT))[wg * 8 + F.tid] = cnt; }
    LDS_WAIT(); __syncthreads();
    if (F.tid < 128) { ((int*)(ws + WS_TOPE))[t0 * 2 + F.tid] = se[F.tid]; ((int*)(ws + WS_RANK))[t0 * 2 + F.tid] = rk[F.tid]; }
    LDS_WAIT(); __syncthreads();
}
__device__ __forceinline__ void route_pass2(Frame& F_, unsigned char* ws, const float* H) {
    Frame F = F_; asm volatile("" : "+v"(F.lane), "+v"(F.tid));
    const int wg = blockIdx.x, t0 = wg * 64;
    LAS int* cnt = (LAS int*)(F.lds + RING_OFF);
    LAS int* tot = cnt + 2048; LAS int* pre = tot + 8; LAS int* wgoff = pre + 8;
    const int* wgcnt = (const int*)(ws + WS_WGCNT);
    for (int i = F.tid; i < 2048; i += 512) cnt[i] = wgcnt[i];
    LDS_WAIT(); __syncthreads();
    if (F.tid < NE) { int tt = 0, pp = 0; for (int w = 0; w < 256; ++w) { const int c = cnt[w * 8 + F.tid]; pp += (w < wg) ? c : 0; tt += c; } tot[F.tid] = tt; pre[F.tid] = pp; }
    LDS_WAIT(); __syncthreads();
    if (F.tid == 0) { int eb = 0; for (int e = 0; e < NE; ++e) { F.MISC[16 + e] = (unsigned)(eb >> 8); wgoff[e] = eb + pre[e]; eb += (tot[e] + 255) & ~255; } F.MISC[24] = (unsigned)(eb >> 8); }
    LDS_WAIT(); __syncthreads();
    const int* tope = (const int*)(ws + WS_TOPE); const int* rank = (const int*)(ws + WS_RANK); const float* invf = (const float*)(ws + WS_INVF);
    int* slot = (int*)(ws + WS_SLOT); bf16_t* xp = (bf16_t*)(ws + WS_XP);
    for (int i = 0; i < 8; ++i) {
        const int t = t0 + F.wave * 8 + i;
        const int s0 = wgoff[tope[2 * t]] + rank[2 * t], s1 = wgoff[tope[2 * t + 1]] + rank[2 * t + 1];
        const float inv = invf[t];
        const f32x4* hr = (const f32x4*)(H + (size_t)t * D) + F.lane;
        u32x2* o0 = (u32x2*)(xp + (size_t)s0 * D) + F.lane; u32x2* o1 = (u32x2*)(xp + (size_t)s1 * D) + F.lane;
#pragma unroll
        for (int j = 0; j < 4; ++j) { const f32x4 v = hr[64 * j] * inv; u32x2 w; w.x = pk2(v[0], v[1]); w.y = pk2(v[2], v[3]); o0[64 * j] = w; o1[64 * j] = w; }
        if (F.lane == 0) { slot[2 * t] = s0; slot[2 * t + 1] = s1; }
    }
    LDS_WAIT(); __syncthreads();
}
__device__ __forceinline__ void final_pass(Frame& F_, unsigned char* ws, float* H, const float* gain) {
    Frame F = F_; asm volatile("" : "+v"(F.lane), "+v"(F.tid));
    const int gw = F.vcu * NWAVES + F.wave, NGW = F.G * NWAVES;
    const int* slot = (const int*)(ws + WS_SLOT); const float* topw = (const float*)(ws + WS_TOPW); const bf16_t* yp = (const bf16_t*)(ws + WS_YP);
    for (int t = gw; t < M; t += NGW) {
        const int s0 = slot[2 * t], s1 = slot[2 * t + 1]; const float w0 = topw[2 * t], w1 = topw[2 * t + 1];
        f32x4* hr = (f32x4*)(H + (size_t)t * D) + F.lane;
        const u32x2* y0 = (const u32x2*)(yp + (size_t)s0 * D) + F.lane; const u32x2* y1 = (const u32x2*)(yp + (size_t)s1 * D) + F.lane;
        f32x4 v[4]; float s = 0.f;
#pragma unroll
        for (int j = 0; j < 4; ++j) { const u32x2 a = y0[64 * j], b = y1[64 * j]; v[j] = hr[64 * j];
            v[j][0] += w0 * bflo(a.x) + w1 * bflo(b.x); v[j][1] += w0 * bfhi(a.x) + w1 * bfhi(b.x); v[j][2] += w0 * bflo(a.y) + w1 * bflo(b.y); v[j][3] += w0 * bfhi(a.y) + w1 * bfhi(b.y);
            s += (v[j][0] * v[j][0] + v[j][1] * v[j][1]) + (v[j][2] * v[j][2] + v[j][3] * v[j][3]); }
        s = wave_sum(s);
        const float inv = rsqrtf(s * (1.0f / D) + EPS);
#pragma unroll
        for (int j = 0; j < 4; ++j) { const f32x4 g4 = *((const f32x4*)gain + F.lane + 64 * j); hr[64 * j] = (v[j] * inv) * g4; }
    }
}

__device__ __forceinline__ unsigned long long karg(int idx) {
    const __attribute__((address_space(4))) unsigned long long* p = (const __attribute__((address_space(4))) unsigned long long*)__builtin_amdgcn_kernarg_segment_ptr();
    asm volatile("" : "+s"(p));
    return p[idx];
}
#define KIN(i) ((const float*)karg(i))
#define KOUT() ((float*)karg(22))
#define KWS() ((unsigned char*)karg(23))

__global__ void __launch_bounds__(NWAVES * 64, 2) mk_fwd(Args args) {
    extern __shared__ __attribute__((aligned(16))) unsigned char lds[];
    Frame F;
    F.lds = (LAS unsigned char*)lds; F.MISC = (volatile LAS unsigned*)(F.lds + MISC_OFF);
    F.tid = threadIdx.x; F.lane = F.tid & 63; F.wave = __builtin_amdgcn_readfirstlane(F.tid >> 6);
    F.G = gridDim.x; { const int bx = blockIdx.x; F.vcu = (F.G % 8 == 0) ? (bx % 8) * (F.G / 8) + bx / 8 : bx; }
    for (int u = F.tid; u < (LDS_BYTES - LDSCTL_OFF) / 4; u += NWAVES * 64) ((LAS unsigned*)(F.lds + LDSCTL_OFF))[u] = 0u;
    __syncthreads();
    XcdBarrier bar = xcd_barrier_post((unsigned*)(args.ws + WS_CTL) + CW_BAR, F.MISC + 8);
#define GRID_BAR() xcd_barrier(bar)
    const int cid = (int)blockIdx.x;

    p0_rows(F, KWS(), KIN(0), (const int*)KIN(1));
    GRID_BAR();

#pragma unroll 1
    for (int l = 0; l < 2; ++l) {
        { unsigned char* ws = KWS(); pg8::StaticOrder S; S.init(M / 256, NV1 / 256, F.G, cid);
          EpiProj E{ws, KIN(4) + l * 2048};
          naive_gemm_phase(F.lds, (const bf16_t*)(ws + WS_HB), D, S, E, WProj{KIN(3) + (size_t)l * D * INC, KIN(2) + l * D}); }
        GRID_BAR();
        { unsigned char* ws = KWS(); pg8::StaticOrder S; S.init(M / 256, 1536 / 256, F.G, cid); EpiQ E{ws};
          naive_gemm_phase(F.lds, (const bf16_t*)(ws + WS_CQ), QL, S, E, WQ{KIN(9) + (size_t)l * QL * 1536, KIN(7) + l * QL}); }
        { unsigned char* ws = KWS(); pg8::StaticOrder S; S.init(M / 256, 2048 / 256, F.G, cid); EpiKV E{ws};
          naive_gemm_phase(F.lds, (const bf16_t*)(ws + WS_CKV), KVL, S, E, WKV{KIN(10) + (size_t)l * KVL * 2048, KIN(8) + l * KVL}); }
        conv_pass(F, KWS(), KIN(5) + l * 3 * 1024);
        GRID_BAR();
        naive_attention(F, KWS());
        GRID_BAR();
        { unsigned char* ws = KWS(); pg8::StaticOrder S; S.init(M / 256, 4, F.G, cid); EpiGate<0> E{ws};
          naive_gemm_phase(F.lds, (const bf16_t*)(ws + WS_GB), D, S, E, WPlain{KIN(6) + (size_t)l * D * D, D, 0}); }
        VM_WAIT(); __syncthreads();
        { unsigned char* ws = KWS(); pg8::StaticOrder S; S.init(M / 256, 4, F.G, cid); EpiGate<1> E{ws};
          naive_gemm_phase(F.lds, (const bf16_t*)(ws + WS_O), D, S, E, WPlain{KIN(11) + (size_t)l * D * D, D, 0}); }
        GRID_BAR();
        { unsigned char* ws = KWS(); pg8::StaticOrder S; S.init(M / 256, 4, F.G, cid); EpiResid E{l == 0 ? KIN(0) : (const float*)KOUT(), KOUT(), ws};
          naive_gemm_phase(F.lds, (const bf16_t*)(ws + WS_MX), D, S, E, WPlain{KIN(12) + (size_t)l * D * D, D, 0}); }
        GRID_BAR();
        if (l == 0) {
            { unsigned char* ws = KWS(); pg8::StaticOrder S; S.init(M / 256, 22, F.G, cid); EpiSwiglu E{(const float*)(ws + WS_SSQH), (bf16_t*)(ws + WS_ACT), FFD};
              naive_gemm_phase(F.lds, (const bf16_t*)(ws + WS_HB), D, S, E, WGU{KIN(14), KIN(15), KIN(13) + l * D, FFD, 0}); }
            GRID_BAR();
            { unsigned char* ws = KWS(); pg8::StaticOrder S; S.init(M / 256, 4, F.G, cid); EpiResid E{KOUT(), KOUT(), ws};
              naive_gemm_phase(F.lds, (const bf16_t*)(ws + WS_ACT), FFD, S, E, WPlain{KIN(16), D, 0}); }
            GRID_BAR();
        } else {
            route_pass1(F, KWS(), KOUT(), KIN(13) + l * D, KIN(17));
            GRID_BAR();
            route_pass2(F, KWS(), KOUT());
            GRID_BAR();
            { unsigned char* ws = KWS(); pg8::StaticOrder S; S.init((int)F.MISC[24], 14, F.G, cid, F.MISC + 16); EpiSwiglu E{nullptr, (bf16_t*)(ws + WS_ACTE), FFE};
              naive_gemm_phase(F.lds, (const bf16_t*)(ws + WS_XP), D, S, E, WGU{KIN(18), KIN(19), KIN(13) + l * D, FFE, (size_t)D * FFE}); }
            GRID_BAR();
            { unsigned char* ws = KWS(); pg8::StaticOrder S; S.init((int)F.MISC[24], 4, F.G, cid, F.MISC + 16); EpiStore E{(bf16_t*)(ws + WS_YP), D};
              naive_gemm_phase(F.lds, (const bf16_t*)(ws + WS_ACTE), FFE, S, E, WPlain{KIN(20), D, (size_t)FFE * D}); }
            GRID_BAR();
            final_pass(F, KWS(), KOUT(), KIN(21));
        }
    }
}

extern "C" void kernel_launch(void* const* d_in, const int* in_sizes, int n_in, void* d_out, int out_size, void* d_ws, size_t ws_size, hipStream_t stream) {
    static int grid = 0;
    if (grid == 0) {
        if (n_in != 22 || in_sizes[0] != M * D || out_size != M * D || ws_size < WS_END) { fprintf(stderr, "kernel_launch: unexpected shapes (n_in %d, out %d, ws %zu < %zu)\n", n_in, out_size, ws_size, (size_t)WS_END); grid = -1; return; }
        int dev = 0, cus = 0;
        if (hipGetDevice(&dev) != hipSuccess || hipDeviceGetAttribute(&cus, hipDeviceAttributeMultiprocessorCount, dev) != hipSuccess) { grid = -1; return; }
        if (hipFuncSetAttribute((const void*)mk_fwd, hipFuncAttributeMaxDynamicSharedMemorySize, LDS_BYTES) != hipSuccess) { fprintf(stderr, "kernel_launch: hipFuncSetAttribute failed\n"); grid = -1; return; }
        (void)hipGetLastError();
        grid = cus;
        if (grid != 256) { fprintf(stderr, "kernel_launch: built for 256 CUs, found %d\n", cus); grid = -1; return; }
    }
    if (grid < 0) return;
    (void)hipMemsetAsync((char*)d_ws + WS_CTL, 0, CTL_ZERO_BYTES, stream);
    Args a{};
    for (int i = 0; i < 22; ++i) a.in[i] = (const float*)d_in[i];
    a.out = (float*)d_out; a.ws = (unsigned char*)d_ws;
    hipLaunchKernelGGL(mk_fwd, dim3(grid), dim3(NWAVES * 64), LDS_BYTES, stream, a);
}
```

```cpp
#include <hip/hip_runtime.h>
#include <cstdio>
#include <cstdint>

#ifndef FAST_GEMM_MASK
#define FAST_GEMM_MASK 0x3ffu
#endif
#ifndef FAST_ATTN
#define FAST_ATTN 0
#endif
enum { GP_PROJ = 0, GP_QUP = 1, GP_KVUP = 2, GP_CONVOUT = 3, GP_ATTNOUT = 4, GP_MIXOUT = 5, GP_FFUP = 6, GP_FFDOWN = 7, GP_MOEUP = 8, GP_MOEDOWN = 9 };
#define FASTG(i) (((FAST_GEMM_MASK) >> (i)) & 1u)

constexpr int M = 16384, D = 1024, SEQ = 2048, NB = 8, NH = 16, QKD = 96, VD = 64, QL = 256, KVL = 128;
constexpr int INC = 5536, NV1 = 5632;
constexpr int FFD = 2816, NE = 8, FFE = 1792;
constexpr int SPMAX = 34816;
constexpr float EPS = 1e-6f;
constexpr float C2 = 0.14724444602590306f;
constexpr int NWAVES = 8;

#define GAS __attribute__((address_space(1)))
#define LAS __attribute__((address_space(3)))
typedef unsigned short bf16_t;
typedef short bf16x8 __attribute__((ext_vector_type(8)));
typedef float f32x4 __attribute__((ext_vector_type(4)));
typedef float f32x2 __attribute__((ext_vector_type(2)));
typedef unsigned u32x4 __attribute__((ext_vector_type(4)));
typedef unsigned u32x2 __attribute__((ext_vector_type(2)));
typedef int i32x2 __attribute__((ext_vector_type(2)));
typedef __bf16 bf16x2_t __attribute__((ext_vector_type(2)));
typedef GAS unsigned gu32;

__device__ __forceinline__ unsigned pk2(float lo, float hi) { f32x2 v = {lo, hi}; bf16x2_t b = __builtin_convertvector(v, bf16x2_t); return __builtin_bit_cast(unsigned, b); }
__device__ __forceinline__ float bflo(unsigned u) { return __uint_as_float(u << 16); }
__device__ __forceinline__ float bfhi(unsigned u) { return __uint_as_float(u & 0xffff0000u); }
__device__ __forceinline__ float bf2f(bf16_t b) { return __uint_as_float((unsigned)b << 16); }
__device__ __forceinline__ u32x4 pack8(const float* v) { u32x4 w; w.x = pk2(v[0], v[1]); w.y = pk2(v[2], v[3]); w.z = pk2(v[4], v[5]); w.w = pk2(v[6], v[7]); return w; }
__device__ __forceinline__ void unpack8(u32x4 w, float* v) { v[0] = bflo(w.x); v[1] = bfhi(w.x); v[2] = bflo(w.y); v[3] = bfhi(w.y); v[4] = bflo(w.z); v[5] = bfhi(w.z); v[6] = bflo(w.w); v[7] = bfhi(w.w); }
__device__ __forceinline__ float sigmoidf_(float x) { return 1.0f / (1.0f + __expf(-x)); }
__device__ __forceinline__ float wave_sum(float v) {
#pragma unroll
    for (int o = 1; o < 64; o <<= 1) v += __shfl_xor(v, o);
    return v;
}
__device__ __forceinline__ int lane_id_opaque() { int l; asm volatile("v_mbcnt_lo_u32_b32 %0, -1, 0\n\tv_mbcnt_hi_u32_b32 %0, -1, %0" : "=v"(l)); return l; }
#define LDS_WAIT() asm volatile("s_waitcnt lgkmcnt(0)" ::: "memory")
#define VM_WAIT() asm volatile("s_waitcnt vmcnt(0)" ::: "memory")

constexpr size_t MiB = 1u << 20;
constexpr size_t WS_CTL = 0, CTL_ZERO_BYTES = 64 * 1024;
constexpr size_t WS_COS = 1 * MiB, WS_SIN = 2 * MiB;
constexpr size_t WS_SSQH = 3 * MiB;
constexpr size_t WS_SSQQ = 4 * MiB, WS_SSQKV = WS_SSQQ + 256 * 1024;
constexpr size_t WS_TOPE = WS_SSQKV + 256 * 1024;
constexpr size_t WS_TOPW = WS_TOPE + 128 * 1024;
constexpr size_t WS_RANK = WS_TOPW + 128 * 1024;
constexpr size_t WS_SLOT = WS_RANK + 128 * 1024;
constexpr size_t WS_INVF = WS_SLOT + 128 * 1024;
constexpr size_t WS_WGCNT = WS_INVF + 64 * 1024;
static_assert(WS_WGCNT + 8192 <= 6 * MiB, "small tables");
constexpr size_t WS_HB = 6 * MiB;
constexpr size_t WS_V = WS_HB;
constexpr size_t WS_MW = 38 * MiB, MW_LAYER = 18 * MiB + 512 * 1024;
constexpr size_t MW_WIN = 0, MW_WCO = 11 * MiB, MW_WAO = 13 * MiB, MW_WMX = 15 * MiB, MW_WUQ = 17 * MiB, MW_WUKV = 17 * MiB + 768 * 1024;
constexpr size_t WS_WGU = 75 * MiB, WS_WD = 86 * MiB;
constexpr size_t WS_Z0 = 92 * MiB, WS_GB = 124 * MiB, WS_CQ = 156 * MiB, WS_CKV = 164 * MiB, WS_G = 168 * MiB, WS_Q = 232 * MiB, WS_K = 280 * MiB;
constexpr size_t WS_O = WS_Z0, WS_MX = WS_Q, WS_ACT = 92 * MiB;
constexpr size_t WS_WGUE = 38 * MiB, WS_WDE = 94 * MiB, WS_XP = 122 * MiB, WS_YP = WS_XP, WS_ACTE = 190 * MiB;
constexpr size_t WS_END = 328 * MiB;
static_assert(WS_K + (size_t)M * 1536 * 2 <= WS_END && WS_ACTE + (size_t)SPMAX * FFE * 2 <= WS_END && WS_ACT + (size_t)M * FFD * 2 <= WS_Q, "ws map");
static_assert(WS_WGUE + (size_t)NE * 3584 * 1024 * 2 <= WS_WDE && WS_WDE + (size_t)NE * 1024 * FFE * 2 <= WS_XP && WS_XP + (size_t)SPMAX * 1024 * 2 <= WS_ACTE, "moe map");
constexpr int CW_TMO = 0, CW_BAR = 1024;

constexpr int RING_OFF = 0, RING_BYTES = 131072;
constexpr int LDSCTL_OFF = RING_BYTES, MISC_OFF = LDSCTL_OFF + 320;
constexpr int LDS_BYTES = 147456;

__device__ __forceinline__ int vmap_in(int v) {
    const int t = v >> 8, j = v & 255;
    if (t < 8) return (j < 128) ? (1024 + 128 * t + j) : (2048 + 128 * t + (j - 128));
    if (t < 12) return 256 * (t - 8) + j;
    if (t == 12) return 3072 + j;
    if (t == 13) { if (j < 128) return 3328 + j; if (j < 160) { const int p = (j - 128) >> 1, odd = (j - 128) & 1; return 3456 + p + 16 * odd; } return -1; }
    return 3488 + 256 * (t - 14) + j;
}
__device__ __forceinline__ int vmap_q(int v) { const int h = v / 96, d = v % 96; if (d < 64) return v; const int p = (d - 64) >> 1, odd = (d - 64) & 1; return 96 * h + 64 + p + 16 * odd; }

struct WProj { const float* w; const float* gain; __device__ __forceinline__ float operator()(int k, int v, int) const { const int o = vmap_in(v); return o < 0 ? 0.f : gain[k] * w[(size_t)k * INC + o]; } };
struct WQ { const float* w; const float* gain; __device__ __forceinline__ float operator()(int k, int v, int) const { return gain[k] * w[(size_t)k * 1536 + vmap_q(v)]; } };
struct WKV { const float* w; const float* gain; __device__ __forceinline__ float operator()(int k, int v, int) const { return gain[k] * w[(size_t)k * 2048 + v]; } };
struct WPlain { const float* w; int ldn; size_t estride; __device__ __forceinline__ float operator()(int k, int v, int e) const { return w[(size_t)e * estride + (size_t)k * ldn + v]; } };
struct WGU { const float* wg; const float* wu; const float* gain; int ff; size_t estride;
    __device__ __forceinline__ float operator()(int k, int v, int e) const { const int t = v >> 8, j = v & 255; const size_t o = (size_t)e * estride + (size_t)k * ff + 128 * t + (j & 127);
        const size_t delta = (size_t)((const char*)wu - (const char*)wg);
        const float* p = (const float*)((const char*)wg + ((j >= 128) ? delta : (size_t)0)); return gain[k] * p[o]; } };

namespace pg8 {
constexpr int BM = 256, BK = 64, HALF = 128, HTB = HALF * BK * 2, STAGE_BYTES = 8 * HTB, NXCD = 8, WGM = 8;
__device__ __forceinline__ int lds_byte(int r, int c) { const int st = (r >> 4) * 2 + (c >> 5), rr = r & 15, cc = c & 31, ob = rr * 64 + cc * 2; return st * 1024 + (ob ^ (((ob >> 9) & 1) << 5)); }
__device__ __forceinline__ void stage_rc(int b, int& R, int& C) { const int st = b / 1024, sb = b % 1024, swz = sb ^ (((sb >> 9) & 1) << 5); R = (st >> 1) * 16 + swz / 64; C = (st & 1) * 32 + (swz % 64) / 2; }
__device__ __forceinline__ int perm32(int rho) { const int n = rho >> 4, i = rho & 15; return 8 * (i >> 2) + 4 * n + (i & 3); }

struct Unit { int pm, pn, e; };
struct Gemm { const bf16_t* A; const bf16_t* Bt; int K; size_t estride; };

struct StaticOrder {
    int nM, nN, nwg, G, c; const volatile LAS unsigned* ebt;
    __device__ void init(int nM_, int nN_, int G_, int c_, const volatile LAS unsigned* ebt_ = nullptr) { nM = nM_; nN = nN_; nwg = nM * nN; G = G_; c = c_; ebt = ebt_; }
    __device__ bool next(int i, Unit& u) const {
        const long L = (long)i * G + c; if (L >= nwg) return false;
        int wgid = (int)L; { const int q = nwg / NXCD, r = nwg % NXCD, xcd = wgid % NXCD, off = wgid / NXCD; wgid = (xcd < r ? xcd * (q + 1) : r * (q + 1) + (xcd - r) * q) + off; }
        const int nig = WGM * nN, gid = wgid / nig, fm = gid * WGM, gsz = (nM - fm) < WGM ? (nM - fm) : WGM;
        u.pm = fm + ((wgid % nig) % gsz); u.pn = (wgid % nig) / gsz; u.e = 0;
        if (ebt) { int e = 0;
#pragma unroll
            for (int j = 1; j < NE; ++j) e += ((int)ebt[j] <= u.pm) ? 1 : 0;
            u.e = e; }
        return true;
    }
};
typedef f32x4 f32x4_;
template <class Epi, class Sched, bool ALIGN_EPI = false, bool SP2 = false>
__device__ __forceinline__ void gemm_phase(LAS unsigned char* lds, const Gemm g, const Sched& S, const Epi& E, int wave_) {
    const int lane = lane_id_opaque(), wid = wave_, tid = wid * 64 + lane, wr = wid >> 2, wc = wid & 3, fr = lane & 15, fq = lane >> 4;
    const int K = g.K, nt = K / BK;
    unsigned voffA[2], voffB[2];
#pragma unroll
    for (int i = 0; i < 2; ++i) { int R, C; stage_rc(tid * 16 + i * 8192, R, C); const int Rb = Epi::PERM ? ((R & ~31) + perm32(R & 31)) : R;
        voffA[i] = (unsigned)(R * K + C) * 2u; voffB[i] = (unsigned)(Rb * K + C) * 2u; }
    const size_t kstep = (size_t)(BK * 2);
    const size_t hstep = (size_t)HALF * K * 2;
    const size_t tstep = 2 * hstep;
    const unsigned ldsw = (unsigned)wid * 1024u;
    const int aoff = lds_byte(wr * 64 + fr, fq * 8), boff = lds_byte(wc * 32 + fr, fq * 8);
#define PG8_SA(b, h) (((b) * 2 + (h)) * HTB)
#define PG8_SB(b, h) ((4 + (b) * 2 + (h)) * HTB)
#define PG8_STAGE(bufoff, gbase, voff) do { _Pragma("unroll") for (int _i = 0; _i < 2; ++_i) \
        __builtin_amdgcn_global_load_lds((const unsigned*)((const char*)(gbase) + (voff)[_i]), (LAS unsigned*)(lds + (bufoff) + ldsw + _i * 8192), 16, 0, 0); } while (0)
#define PG8_LDA(dst, b, h) do { _Pragma("unroll") for (int m = 0; m < 4; ++m) _Pragma("unroll") for (int k = 0; k < 2; ++k) dst[m][k] = *(const LAS bf16x8*)(lds + PG8_SA(b, h) + aoff + m * 2048 + k * 1024); } while (0)
#define PG8_LDB(dst, b, h) do { _Pragma("unroll") for (int n = 0; n < 2; ++n) _Pragma("unroll") for (int k = 0; k < 2; ++k) dst[n][k] = *(const LAS bf16x8*)(lds + PG8_SB(b, h) + boff + n * 2048 + k * 1024); } while (0)
#define PG8_MMA(ai, bj, At, Bt) do { __builtin_amdgcn_s_setprio(1); _Pragma("unroll") for (int m = 0; m < 4; ++m) _Pragma("unroll") for (int n = 0; n < 2; ++n) _Pragma("unroll") for (int k = 0; k < 2; ++k) \
        acc[ai][bj][m][n] = __builtin_amdgcn_mfma_f32_16x16x32_bf16(Bt[n][k], At[m][k], acc[ai][bj][m][n], 0, 0, 0); __builtin_amdgcn_s_setprio(0); } while (0)
#define PG8_WAIT_V(n) asm volatile("s_waitcnt vmcnt(" #n ")" ::: "memory")
#define PG8_WAIT_L(n) asm volatile("s_waitcnt lgkmcnt(" #n ")" ::: "memory")
#define PG8_BAR __builtin_amdgcn_s_barrier()
#define PG8_SCHED __builtin_amdgcn_sched_barrier(0)
    Unit cur, nxt; int ui = 0;
    if (!S.next(0, cur)) return;
    f32x4 acc[2][2][4][2];
#pragma unroll
    for (int a = 0; a < 2; ++a)
#pragma unroll
        for (int b = 0; b < 2; ++b)
#pragma unroll
            for (int m = 0; m < 4; ++m)
#pragma unroll
                for (int n = 0; n < 2; ++n) acc[a][b][m][n] = (f32x4){0.f, 0.f, 0.f, 0.f};
    bf16x8 At[4][2], B0[2][2], B1[2][2];
    const char* cA = (const char*)g.A + (size_t)cur.pm * tstep; const char* cB = (const char*)g.Bt + (size_t)cur.e * g.estride * 2 + (size_t)cur.pn * tstep;
    if constexpr (SP2) {
        PG8_STAGE(PG8_SB(0, 0), cB, voffB); PG8_STAGE(PG8_SB(0, 1), cB + hstep, voffB); PG8_STAGE(PG8_SA(0, 0), cA, voffA); PG8_STAGE(PG8_SA(0, 1), cA + hstep, voffA);
        if (wr == 1) PG8_BAR;
        PG8_WAIT_V(2); PG8_BAR;
        PG8_STAGE(PG8_SB(1, 0), cB + kstep, voffB); PG8_STAGE(PG8_SA(1, 0), cA + kstep, voffA); PG8_STAGE(PG8_SB(1, 1), cB + hstep + kstep, voffB);
        PG8_WAIT_V(6); PG8_BAR;
    } else {
        PG8_STAGE(PG8_SB(0, 0), cB, voffB); PG8_STAGE(PG8_SA(0, 0), cA, voffA); PG8_STAGE(PG8_SB(0, 1), cB + hstep, voffB); PG8_STAGE(PG8_SA(0, 1), cA + hstep, voffA);
        if (wr == 1) PG8_BAR;
        PG8_WAIT_V(4); PG8_BAR;
        PG8_STAGE(PG8_SB(1, 0), cB + kstep, voffB); PG8_STAGE(PG8_SA(1, 0), cA + kstep, voffA); PG8_STAGE(PG8_SB(1, 1), cB + hstep + kstep, voffB);
        PG8_WAIT_V(6); PG8_BAR;
    }
    for (;;) {
        const bool has_next = S.next(ui + 1, nxt);
        const char* nA = has_next ? (const char*)g.A + (size_t)nxt.pm * tstep : cA; const char* nB = has_next ? (const char*)g.Bt + (size_t)nxt.e * g.estride * 2 + (size_t)nxt.pn * tstep : cB;
        for (int t = 0; t < nt; t += 2) {
            const bool last = (t == nt - 2);
            const char* a1 = cA + (size_t)(t + 1) * kstep;
            const char* a2 = last ? nA : cA + (size_t)(t + 2) * kstep; const char* b2 = last ? nB : cB + (size_t)(t + 2) * kstep;
            const char* a3 = a2 + kstep; const char* b3 = b2 + kstep;
            if constexpr (SP2) {
            PG8_LDB(B0, 0, 0); PG8_LDB(B1, 0, 1); PG8_SCHED; PG8_LDA(At, 0, 0); PG8_STAGE(PG8_SA(1, 1), a1 + hstep, voffA);
            PG8_WAIT_V(8); PG8_WAIT_L(0); PG8_BAR; PG8_MMA(0, 0, At, B0); PG8_MMA(0, 1, At, B1); PG8_BAR; PG8_SCHED;
            PG8_LDA(At, 0, 1); PG8_STAGE(PG8_SB(0, 0), b2, voffB); PG8_STAGE(PG8_SB(0, 1), b2 + hstep, voffB); PG8_STAGE(PG8_SA(0, 0), a2, voffA);
            PG8_WAIT_V(8); PG8_WAIT_L(0); PG8_BAR; PG8_MMA(1, 0, At, B0); PG8_MMA(1, 1, At, B1); PG8_BAR; PG8_SCHED;
            PG8_LDB(B0, 1, 0); PG8_LDB(B1, 1, 1); PG8_SCHED; PG8_LDA(At, 1, 0); PG8_STAGE(PG8_SA(0, 1), a2 + hstep, voffA);
            PG8_WAIT_V(8); PG8_WAIT_L(0); PG8_BAR; PG8_MMA(0, 0, At, B0); PG8_MMA(0, 1, At, B1); PG8_BAR; PG8_SCHED;
            PG8_LDA(At, 1, 1); PG8_STAGE(PG8_SB(1, 0), b3, voffB); PG8_STAGE(PG8_SB(1, 1), b3 + hstep, voffB); PG8_STAGE(PG8_SA(1, 0), a3, voffA);
            PG8_WAIT_V(8); PG8_WAIT_L(0); PG8_BAR; PG8_MMA(1, 0, At, B0); PG8_MMA(1, 1, At, B1); PG8_BAR; PG8_SCHED;
            } else {
            PG8_LDB(B0, 0, 0); PG8_SCHED; PG8_LDA(At, 0, 0); PG8_STAGE(PG8_SA(1, 1), a1 + hstep, voffA);
            PG8_WAIT_L(8); PG8_BAR; PG8_WAIT_L(0); PG8_MMA(0, 0, At, B0); PG8_BAR; PG8_SCHED;
            PG8_LDB(B1, 0, 1); PG8_STAGE(PG8_SB(0, 0), b2, voffB);
            PG8_BAR; PG8_WAIT_L(0); PG8_MMA(0, 1, At, B1); PG8_BAR;
            PG8_LDA(At, 0, 1); PG8_STAGE(PG8_SA(0, 0), a2, voffA);
            PG8_BAR; PG8_WAIT_L(0); PG8_MMA(1, 0, At, B0); PG8_BAR; PG8_SCHED;
            PG8_STAGE(PG8_SB(0, 1), b2 + hstep, voffB);
            PG8_WAIT_V(6); PG8_BAR; PG8_MMA(1, 1, At, B1); PG8_BAR;
            PG8_LDB(B0, 1, 0); PG8_SCHED; PG8_LDA(At, 1, 0); PG8_STAGE(PG8_SA(0, 1), a2 + hstep, voffA);
            PG8_WAIT_L(8); PG8_BAR; PG8_WAIT_L(0); PG8_MMA(0, 0, At, B0); PG8_BAR; PG8_SCHED;
            PG8_LDB(B1, 1, 1); PG8_STAGE(PG8_SB(1, 0), b3, voffB);
            PG8_BAR; PG8_WAIT_L(0); PG8_MMA(0, 1, At, B1); PG8_BAR;
            PG8_LDA(At, 1, 1); PG8_STAGE(PG8_SA(1, 0), a3, voffA);
            PG8_BAR; PG8_WAIT_L(0); PG8_MMA(1, 0, At, B0); PG8_BAR; PG8_SCHED;
            PG8_STAGE(PG8_SB(1, 1), b3 + hstep, voffB);
            PG8_WAIT_V(6); PG8_BAR; PG8_MMA(1, 1, At, B1); PG8_BAR;
            }
        }
        if constexpr (ALIGN_EPI) { if (wr == 0) PG8_BAR; }
        if constexpr (!Epi::AFTER_DRAIN) { E(acc, cur, wr, wc, fr, fq); }
        if (!has_next) break;
#pragma unroll
        for (int a = 0; a < 2; ++a)
#pragma unroll
            for (int b = 0; b < 2; ++b)
#pragma unroll
                for (int m = 0; m < 4; ++m)
#pragma unroll
                    for (int n = 0; n < 2; ++n) acc[a][b][m][n] = (f32x4){0.f, 0.f, 0.f, 0.f};
        cur = nxt; cA = nA; cB = nB; ++ui;
        if constexpr (ALIGN_EPI) { if (wr == 1) PG8_BAR; }
    }
    PG8_WAIT_V(0);
    if constexpr (!ALIGN_EPI) { if (wr == 0) PG8_BAR; }
    PG8_BAR;
    if constexpr (Epi::AFTER_DRAIN) { E.fused(acc, cur, wr, wc, fr, fq, lds, wid, lane); }
#undef PG8_SA
#undef PG8_SB
#undef PG8_STAGE
#undef PG8_LDA
#undef PG8_LDB
#undef PG8_MMA
#undef PG8_WAIT_V
#undef PG8_WAIT_L
#undef PG8_BAR
#undef PG8_SCHED
}
}
using pg8::Unit;
typedef f32x4 Acc[2][2][4][2];

#define EPI_ROW(ai, m) (u.pm * 256 + (ai) * 128 + wr * 64 + (m) * 16 + fr)
#define EPI_GET8(dst, ai, bj, m, sc) do { const f32x4 _a = acc[ai][bj][m][0], _b = acc[ai][bj][m][1]; dst[0] = _a[0] * (sc); dst[1] = _a[1] * (sc); dst[2] = _a[2] * (sc); dst[3] = _a[3] * (sc); \
        dst[4] = _b[0] * (sc); dst[5] = _b[1] * (sc); dst[6] = _b[2] * (sc); dst[7] = _b[3] * (sc); } while (0)
__device__ __forceinline__ float sum16(const float* p) { const f32x4 a = *(const f32x4*)p, b = *(const f32x4*)(p + 4), c = *(const f32x4*)(p + 8), d = *(const f32x4*)(p + 12);
    return ((a[0] + a[1]) + (a[2] + a[3])) + ((b[0] + b[1]) + (b[2] + b[3])) + ((c[0] + c[1]) + (c[2] + c[3])) + ((d[0] + d[1]) + (d[2] + d[3])); }
__device__ __forceinline__ float sum4(const float* p) { const f32x4 a = *(const f32x4*)p; return (a[0] + a[1]) + (a[2] + a[3]); }
__device__ __forceinline__ float sumsq8(const float* v) { return ((v[0] * v[0] + v[1] * v[1]) + (v[2] * v[2] + v[3] * v[3])) + ((v[4] * v[4] + v[5] * v[5]) + (v[6] * v[6] + v[7] * v[7])); }

struct EpiProj {
    static constexpr bool PERM = true, AFTER_DRAIN = false;
    unsigned char* ws; const float* bgate;
    __device__ __forceinline__ void operator()(const Acc& acc, const Unit& u, int wr, int wc, int fr, int fq) const {
        const int cb = wc * 32 + 8 * fq, pn = u.pn;
        const float* ssqh = (const float*)(ws + WS_SSQH);
#define PROJ_ROWS_BEGIN _Pragma("unroll") for (int ai = 0; ai < 2; ++ai) _Pragma("unroll") for (int m = 0; m < 4; ++m) { const int row = EPI_ROW(ai, m); \
            const float inv = rsqrtf(sum16(ssqh + (size_t)row * 16) * (1.0f / D) + EPS); float v0[8], v1[8]; EPI_GET8(v0, ai, 0, m, inv); EPI_GET8(v1, ai, 1, m, inv);
#define PROJ_ROWS_END }
        if (pn < 8) {
            bf16_t* z0 = (bf16_t*)(ws + WS_Z0);
            PROJ_ROWS_BEGIN
                float z[8];
#pragma unroll
                for (int i = 0; i < 8; ++i) z[i] = v0[i] * v1[i];
                *(u32x4*)(z0 + (size_t)row * 1024 + 128 * pn + cb) = pack8(z);
            PROJ_ROWS_END
        } else if (pn < 12) {
            bf16_t* gb = (bf16_t*)(ws + WS_GB);
            PROJ_ROWS_BEGIN
                bf16_t* p = gb + (size_t)row * 1024 + 256 * (pn - 8) + cb;
                *(u32x4*)p = pack8(v0); *(u32x4*)(p + 128) = pack8(v1);
            PROJ_ROWS_END
        } else if (pn == 12) {
            bf16_t* cq = (bf16_t*)(ws + WS_CQ); float* ssqq = (float*)(ws + WS_SSQQ);
            PROJ_ROWS_BEGIN
                bf16_t* p = cq + (size_t)row * 256 + cb;
                *(u32x4*)p = pack8(v0); *(u32x4*)(p + 128) = pack8(v1);
                float s = sumsq8(v0) + sumsq8(v1); s += __shfl_xor(s, 16); s += __shfl_xor(s, 32);
                if (fq == 0) ssqq[(size_t)row * 4 + wc] = s;
            PROJ_ROWS_END
        } else if (pn == 13) {
            bf16_t* ckv = (bf16_t*)(ws + WS_CKV); float* ssqkv = (float*)(ws + WS_SSQKV); bf16_t* kk = (bf16_t*)(ws + WS_K);
            const float* cs = (const float*)(ws + WS_COS); const float* sn = (const float*)(ws + WS_SIN);
            PROJ_ROWS_BEGIN
                *(u32x4*)(ckv + (size_t)row * 128 + cb) = pack8(v0);
                float s = sumsq8(v0); s += __shfl_xor(s, 16); s += __shfl_xor(s, 32);
                if (fq == 0) ssqkv[(size_t)row * 4 + wc] = s;
                if (wc == 0) {
                    const f32x4 c4 = *(const f32x4*)(cs + (size_t)row * 16 + 4 * fq), s4 = *(const f32x4*)(sn + (size_t)row * 16 + 4 * fq);
                    float r[8];
#pragma unroll
                    for (int j = 0; j < 4; ++j) { const float t1 = v1[2 * j], t2 = v1[2 * j + 1]; r[2 * j] = t1 * c4[j] - t2 * s4[j]; r[2 * j + 1] = t1 * s4[j] + t2 * c4[j]; }
                    const u32x4 w = pack8(r);
                    bf16_t* kp = kk + (size_t)row * 1536 + 64 + 8 * fq;
#pragma unroll
                    for (int h = 0; h < NH; ++h) *(u32x4*)(kp + 96 * h) = w;
                }
            PROJ_ROWS_END
        } else {
            bf16_t* g = (bf16_t*)(ws + WS_G);
            const int c = 256 * (pn - 14) + cb;
            const f32x4 b0 = *(const f32x4*)(bgate + c), b1 = *(const f32x4*)(bgate + c + 4), b2 = *(const f32x4*)(bgate + c + 128), b3 = *(const f32x4*)(bgate + c + 132);
            PROJ_ROWS_BEGIN
                float g0[8], g1[8];
#pragma unroll
                for (int i = 0; i < 4; ++i) { g0[i] = sigmoidf_(v0[i] + b0[i]); g0[4 + i] = sigmoidf_(v0[4 + i] + b1[i]); g1[i] = sigmoidf_(v1[i] + b2[i]); g1[4 + i] = sigmoidf_(v1[4 + i] + b3[i]); }
                bf16_t* p = g + (size_t)row * 2048 + c;
                *(u32x4*)p = pack8(g0); *(u32x4*)(p + 128) = pack8(g1);
            PROJ_ROWS_END
        }
#undef PROJ_ROWS_BEGIN
#undef PROJ_ROWS_END
    }
};

struct EpiQ {
    static constexpr bool PERM = true, AFTER_DRAIN = false;
    unsigned char* ws;
    __device__ __forceinline__ void operator()(const Acc& acc, const Unit& u, int wr, int wc, int fr, int fq) const {
        const float* ssqq = (const float*)(ws + WS_SSQQ); const float* cs = (const float*)(ws + WS_COS); const float* sn = (const float*)(ws + WS_SIN); bf16_t* q = (bf16_t*)(ws + WS_Q);
#pragma unroll
        for (int ai = 0; ai < 2; ++ai)
#pragma unroll
            for (int m = 0; m < 4; ++m) {
                const int row = EPI_ROW(ai, m);
                const float inv = rsqrtf(sum4(ssqq + (size_t)row * 4) * (1.0f / QL) + EPS) * C2;
#pragma unroll
                for (int bj = 0; bj < 2; ++bj) {
                    float v[8]; EPI_GET8(v, ai, bj, m, inv);
                    const int c = u.pn * 256 + bj * 128 + wc * 32 + 8 * fq, d = c % 96;
                    if (d >= 64) { const int p0 = (d - 64) >> 1;
                        const f32x4 c4 = *(const f32x4*)(cs + (size_t)row * 16 + p0), s4 = *(const f32x4*)(sn + (size_t)row * 16 + p0);
#pragma unroll
                        for (int j = 0; j < 4; ++j) { const float t1 = v[2 * j], t2 = v[2 * j + 1]; v[2 * j] = t1 * c4[j] - t2 * s4[j]; v[2 * j + 1] = t1 * s4[j] + t2 * c4[j]; } }
                    *(u32x4*)(q + (size_t)row * 1536 + c) = pack8(v);
                }
            }
    }
};
struct EpiKV {
    static constexpr bool PERM = true, AFTER_DRAIN = false;
    unsigned char* ws;
    __device__ __forceinline__ void operator()(const Acc& acc, const Unit& u, int wr, int wc, int fr, int fq) const {
        const float* ssqkv = (const float*)(ws + WS_SSQKV); bf16_t* kk = (bf16_t*)(ws + WS_K); bf16_t* vv = (bf16_t*)(ws + WS_V);
#pragma unroll
        for (int ai = 0; ai < 2; ++ai)
#pragma unroll
            for (int m = 0; m < 4; ++m) {
                const int row = EPI_ROW(ai, m);
                const float inv = rsqrtf(sum4(ssqkv + (size_t)row * 4) * (1.0f / KVL) + EPS);
#pragma unroll
                for (int bj = 0; bj < 2; ++bj) {
                    float v[8]; EPI_GET8(v, ai, bj, m, inv);
                    const int c = u.pn * 256 + bj * 128 + wc * 32 + 8 * fq, h = c >> 7, j = c & 127;
                    if (j < 64) *(u32x4*)(kk + (size_t)row * 1536 + 96 * h + j) = pack8(v);
                    else *(u32x4*)(vv + (size_t)row * 1024 + 64 * h + (j - 64)) = pack8(v);
                }
            }
    }
};
template <int MODE> struct EpiGate {
    static constexpr bool PERM = true, AFTER_DRAIN = false;
    unsigned char* ws;
    __device__ __forceinline__ void operator()(const Acc& acc, const Unit& u, int wr, int wc, int fr, int fq) const {
        const bf16_t* g = (const bf16_t*)(ws + WS_G); bf16_t* mx = (bf16_t*)(ws + WS_MX);
#pragma unroll
        for (int ai = 0; ai < 2; ++ai)
#pragma unroll
            for (int m = 0; m < 4; ++m) {
                const int row = EPI_ROW(ai, m);
#pragma unroll
                for (int bj = 0; bj < 2; ++bj) {
                    float v[8]; EPI_GET8(v, ai, bj, m, 1.0f);
                    const int c = u.pn * 256 + bj * 128 + wc * 32 + 8 * fq;
                    float gg[8]; unpack8(*(const u32x4*)(g + (size_t)row * 2048 + MODE * 1024 + c), gg);
                    bf16_t* p = mx + (size_t)row * 1024 + c;
                    if (MODE == 1) { float o[8]; unpack8(*(const u32x4*)p, o);
#pragma unroll
                        for (int i = 0; i < 8; ++i) v[i] = o[i] + gg[i] * v[i]; }
                    else {
#pragma unroll
                        for (int i = 0; i < 8; ++i) v[i] = gg[i] * v[i]; }
                    *(u32x4*)p = pack8(v);
                }
            }
    }
};
struct EpiResid {
    static constexpr bool PERM = true, AFTER_DRAIN = false;
    const float* hin; float* h; unsigned char* ws;
    __device__ __forceinline__ void operator()(const Acc& acc, const Unit& u, int wr, int wc, int fr, int fq) const {
        bf16_t* hb = (bf16_t*)(ws + WS_HB); float* ssqh = (float*)(ws + WS_SSQH);
#pragma unroll
        for (int ai = 0; ai < 2; ++ai)
#pragma unroll
            for (int m = 0; m < 4; ++m) {
                const int row = EPI_ROW(ai, m); float s = 0.f;
#pragma unroll
                for (int bj = 0; bj < 2; ++bj) {
                    float v[8]; EPI_GET8(v, ai, bj, m, 1.0f);
                    const size_t o = (size_t)row * 1024 + u.pn * 256 + bj * 128 + wc * 32 + 8 * fq;
                    const f32x4 r0 = *(const f32x4*)(hin + o), r1 = *(const f32x4*)(hin + o + 4);
#pragma unroll
                    for (int i = 0; i < 4; ++i) { v[i] += r0[i]; v[4 + i] += r1[i]; }
                    *(f32x4*)(h + o) = (f32x4){v[0], v[1], v[2], v[3]}; *(f32x4*)(h + o + 4) = (f32x4){v[4], v[5], v[6], v[7]};
                    *(u32x4*)(hb + o) = pack8(v);
                    s += sumsq8(v);
                }
                s += __shfl_xor(s, 16); s += __shfl_xor(s, 32);
                if (fq == 0) ssqh[(size_t)row * 16 + 4 * u.pn + wc] = s;
            }
    }
};
struct EpiSwiglu {
    static constexpr bool PERM = true, AFTER_DRAIN = false;
    const float* ssqh; bf16_t* act; int ldc;
    __device__ __forceinline__ void operator()(const Acc& acc, const Unit& u, int wr, int wc, int fr, int fq) const {
#pragma unroll
        for (int ai = 0; ai < 2; ++ai)
#pragma unroll
            for (int m = 0; m < 4; ++m) {
                const int row = EPI_ROW(ai, m);
                const float inv = ssqh ? rsqrtf(sum16(ssqh + (size_t)row * 16) * (1.0f / D) + EPS) : 1.0f;
                float v0[8], v1[8]; EPI_GET8(v0, ai, 0, m, inv); EPI_GET8(v1, ai, 1, m, inv);
#pragma unroll
                for (int i = 0; i < 8; ++i) v0[i] = v0[i] * sigmoidf_(v0[i]) * v1[i];
                *(u32x4*)(act + (size_t)row * ldc + 128 * u.pn + wc * 32 + 8 * fq) = pack8(v0);
            }
    }
};
struct EpiStore {
    static constexpr bool PERM = true, AFTER_DRAIN = false;
    bf16_t* o; int ldc;
    __device__ __forceinline__ void operator()(const Acc& acc, const Unit& u, int wr, int wc, int fr, int fq) const {
#pragma unroll
        for (int ai = 0; ai < 2; ++ai)
#pragma unroll
            for (int m = 0; m < 4; ++m) {
                const int row = EPI_ROW(ai, m);
#pragma unroll
                for (int bj = 0; bj < 2; ++bj) { float v[8]; EPI_GET8(v, ai, bj, m, 1.0f);
                    *(u32x4*)(o + (size_t)row * ldc + u.pn * 256 + bj * 128 + wc * 32 + 8 * fq) = pack8(v); }
            }
    }
};

template <class Epi, class WF>
__device__ __forceinline__ void naive_gemm_phase(LAS unsigned char* lds, const bf16_t* A, int K, const pg8::StaticOrder& S, const Epi& E, const WF& wf, int wave_) {
    const int lane = lane_id_opaque(), wid = wave_, tid = wid * 64 + lane, wr = wid >> 2, wc = wid & 3, fr = lane & 15, fq = lane >> 4;
    LAS float* As = (LAS float*)lds;
    LAS float* Ws = As + 16 * 256;
    const int ar = tid >> 1, ak = (tid & 1) * 8, wk = tid >> 5, wcg = (tid & 31) * 8;
    Unit u;
    for (int ui = 0; S.next(ui, u); ++ui) {
        Acc acc;
#pragma unroll
        for (int a = 0; a < 2; ++a)
#pragma unroll
            for (int b = 0; b < 2; ++b)
#pragma unroll
                for (int m = 0; m < 4; ++m)
#pragma unroll
                    for (int n = 0; n < 2; ++n) acc[a][b][m][n] = (f32x4){0.f, 0.f, 0.f, 0.f};
        const bf16_t* arow = A + (size_t)(u.pm * 256 + ar) * K + ak;
#pragma unroll 1
        for (int k0 = 0; k0 < K; k0 += 16) {
            { float af[8]; unpack8(*(const u32x4*)(arow + k0), af);
#pragma unroll
              for (int i = 0; i < 8; ++i) As[(ak + i) * 256 + ar] = af[i];
#pragma unroll
              for (int i = 0; i < 8; ++i) Ws[wk * 256 + wcg + i] = wf(k0 + wk, u.pn * 256 + wcg + i, u.e); }
            LDS_WAIT(); __syncthreads();
#pragma unroll 2
            for (int kk = 0; kk < 16; ++kk) {
                float a[2][4], w[2][8];
#pragma unroll
                for (int ai = 0; ai < 2; ++ai)
#pragma unroll
                    for (int m = 0; m < 4; ++m) a[ai][m] = As[kk * 256 + ai * 128 + wr * 64 + m * 16 + fr];
#pragma unroll
                for (int bj = 0; bj < 2; ++bj)
#pragma unroll
                    for (int i = 0; i < 8; ++i) w[bj][i] = Ws[kk * 256 + bj * 128 + wc * 32 + 8 * fq + i];
#pragma unroll
                for (int ai = 0; ai < 2; ++ai)
#pragma unroll
                    for (int bj = 0; bj < 2; ++bj)
#pragma unroll
                        for (int m = 0; m < 4; ++m)
#pragma unroll
                            for (int n = 0; n < 2; ++n)
#pragma unroll
                                for (int j = 0; j < 4; ++j) acc[ai][bj][m][n][j] += a[ai][m] * w[bj][4 * n + j];
            }
            LDS_WAIT(); __syncthreads();
        }
        E(acc, u, wr, wc, fr, fq);
    }
}


template <bool FAST, bool ALIGN, class Epi, class WF>
__device__ __forceinline__ void run_gemm(LAS unsigned char* lds, const bf16_t* A, const bf16_t* Bt, size_t estride_bt, int K, const pg8::StaticOrder& S, const Epi& E, const WF& wf, int wave_) {
    if constexpr (FAST) { pg8::Gemm g{A, Bt, K, estride_bt}; pg8::gemm_phase<Epi, pg8::StaticOrder, ALIGN, true>(lds, g, S, E, wave_); }
    else naive_gemm_phase(lds, A, K, S, E, wf, wave_);
}

#define XB_TMO      128
#define XB_XCNT(j)  (256  + 64 * (j))
#define XB_XSUB(j)  (1280 + 64 * (j))
#define XB_XGEN(j)  (2304 + 64 * (j))
#define XB_TOP      3328
#define XB_TOPGEN   3392
#define XCD_BAR_WORDS 3456
#define XB_SPIN_CAP (1u << 22)
__device__ __forceinline__ unsigned xb_ld(unsigned* p)              { return __hip_atomic_load(p, __ATOMIC_RELAXED, __HIP_MEMORY_SCOPE_AGENT); }
__device__ __forceinline__ unsigned xb_add(unsigned* p, unsigned v) { return __hip_atomic_fetch_add(p, v, __ATOMIC_RELAXED, __HIP_MEMORY_SCOPE_AGENT); }
__device__ __forceinline__ unsigned xb_xcc_id() { return (unsigned)__builtin_amdgcn_s_getreg((3 << 11) | 20) & 0xFu; }
#define XB_SPIN(cond, bar) do { unsigned _sp = 0; while (cond) { __builtin_amdgcn_s_sleep(1); \
    if ((++_sp & 255u) == 0u) { if (xb_ld(&(bar)[XB_TMO])) break; if (_sp > XB_SPIN_CAP) { atomicAdd(&(bar)[XB_TMO], 1u); break; } } } } while (0)
struct XcdBarrier { unsigned* bar; unsigned x; volatile LAS unsigned* st; };
__device__ __forceinline__ XcdBarrier xcd_barrier_post(unsigned* bar, volatile LAS unsigned* st) {
    XcdBarrier b; b.bar = bar; b.x = xb_xcc_id(); b.st = st;
    if (threadIdx.x == 0) (void)xb_add(&bar[XB_XCNT(b.x)], 1u);
    return b;
}
__device__ __forceinline__ void xcd_barrier_complete(unsigned* bar, unsigned x, unsigned& nloc, unsigned& nx) {
    const unsigned G = gridDim.x * gridDim.y * gridDim.z;
    unsigned sum, cnt, mine, sp = 0u;
    for (;;) {
        sum = 0u; cnt = 0u; mine = 0u;
#pragma unroll
        for (unsigned j = 0; j < 16; ++j) { const unsigned c = xb_ld(&bar[XB_XCNT(j)]); sum += c; cnt += (c > 0u) ? 1u : 0u; mine = (j == x) ? c : mine; }
        if (sum == G) break;
        __builtin_amdgcn_s_sleep(1);
        if ((++sp & 255u) == 0u) { if (xb_ld(&bar[XB_TMO])) break; if (sp > XB_SPIN_CAP) { atomicAdd(&bar[XB_TMO], 1u); break; } }
    }
    nloc = mine > 0u ? mine : 1u; nx = cnt > 0u ? cnt : 1u;
}
__device__ __forceinline__ void xcd_barrier(const XcdBarrier& b, int wave_) {
    asm volatile("s_waitcnt vmcnt(0)" ::: "memory");
    __syncthreads();
    if (wave_ == 0 && lane_id_opaque() == 0) {
        unsigned* bar = b.bar; unsigned bx_ = b.x; asm volatile("" : "+s"(bar), "+s"(bx_));
        __builtin_amdgcn_s_waitcnt(0);
        unsigned nloc = b.st[0], nx = b.st[1];
        if (nloc == 0u) { xcd_barrier_complete(bar, bx_, nloc, nx); b.st[0] = nloc; b.st[1] = nx; }
        const unsigned old = xb_add(&bar[XB_XSUB(bx_)], 1u);
        const unsigned gen = old / nloc;
        if (old + 1u == (gen + 1u) * nloc) {
            __builtin_amdgcn_fence(__ATOMIC_RELEASE, "agent");
            asm volatile("s_waitcnt vmcnt(0)" ::: "memory");
            const unsigned og = xb_add(&bar[XB_TOP], 1u);
            const unsigned tg = og / nx;
            if (og + 1u == (tg + 1u) * nx) xb_add(&bar[XB_TOPGEN], 1u);
            else XB_SPIN(xb_ld(&bar[XB_TOPGEN]) == tg, bar);
            __builtin_amdgcn_fence(__ATOMIC_ACQUIRE, "agent");
            xb_add(&bar[XB_XGEN(bx_)], 1u);
            asm volatile("s_waitcnt vmcnt(0)" ::: "memory");
        } else {
            XB_SPIN(xb_ld(&bar[XB_XGEN(bx_)]) == gen, bar);
            __builtin_amdgcn_fence(__ATOMIC_ACQUIRE, "agent");
            asm volatile("s_waitcnt vmcnt(0)" ::: "memory");
        }
    }
    __syncthreads();
}

struct Args { const float* in[22]; float* out; unsigned char* ws; };
struct Frame {
    LAS unsigned char* lds; volatile LAS unsigned* MISC;
    int tid, lane;
    int wave, vcu, G;
};

__device__ __forceinline__ void p0_rows(Frame& F_, unsigned char* ws, const float* x, const int* pos) {
    Frame F = F_; F.lane = lane_id_opaque(); F.tid = F.wave * 64 + F.lane;
    const int gw = F.vcu * NWAVES + F.wave, NGW = F.G * NWAVES;
    bf16_t* hb = (bf16_t*)(ws + WS_HB); float* ssqh = (float*)(ws + WS_SSQH);
    for (int r = gw; r < M; r += NGW) {
        const f32x4* xr = (const f32x4*)(x + (size_t)r * D) + F.lane; f32x4 v[4]; float s = 0.f;
#pragma unroll
        for (int j = 0; j < 4; ++j) { v[j] = xr[64 * j]; s += (v[j][0] * v[j][0] + v[j][1] * v[j][1]) + (v[j][2] * v[j][2] + v[j][3] * v[j][3]); }
        s = wave_sum(s);
        u32x2* o = (u32x2*)(hb + (size_t)r * D) + F.lane;
#pragma unroll
        for (int j = 0; j < 4; ++j) { u32x2 w; w.x = pk2(v[j][0], v[j][1]); w.y = pk2(v[j][2], v[j][3]); o[64 * j] = w; }
        if (F.lane < 16) ssqh[(size_t)r * 16 + F.lane] = (F.lane == 0) ? s : 0.f;
    }
    float* cs = (float*)(ws + WS_COS); float* sn = (float*)(ws + WS_SIN);
    const double invf[16] = {1.0, 0.5623413251903491, 0.31622776601683794, 0.1778279410038923, 0.1, 0.05623413251903491, 0.03162277660168379, 0.01778279410038923,
                             0.01, 0.005623413251903491, 0.0031622776601683794, 0.0017782794100389228, 0.001, 0.0005623413251903491, 0.00031622776601683794, 0.00017782794100389227};
    for (int idx = (F.vcu * NWAVES + F.wave) * 64 + F.lane; idx < M * 16; idx += NGW * 64) {
        const int r = idx >> 4, i = idx & 15;
        double f = invf[0];
#pragma unroll
        for (int j = 1; j < 16; ++j) f = (i == j) ? invf[j] : f;
        const float angf = (float)pos[r] * (float)f;
        const double a = (double)angf;
        const double n = __builtin_rint(a * 0.6366197723675814);
        const double rr = (a - n * 1.5707963267948966) - n * 6.123233995736766e-17;
        const double r2 = rr * rr;
        const double sp = rr * (1.0 + r2 * (-1.0 / 6 + r2 * (1.0 / 120 + r2 * (-1.0 / 5040 + r2 * (1.0 / 362880 + r2 * (-1.0 / 39916800 + r2 * (1.0 / 6227020800.0)))))));
        const double cp = 1.0 + r2 * (-0.5 + r2 * (1.0 / 24 + r2 * (-1.0 / 720 + r2 * (1.0 / 40320 + r2 * (-1.0 / 3628800 + r2 * (1.0 / 479001600.0))))));
        const int q = ((int)n) & 3;
        const double sv = (q == 0) ? sp : (q == 1) ? cp : (q == 2) ? -sp : -cp;
        const double cv = (q == 0) ? cp : (q == 1) ? -sp : (q == 2) ? -cp : sp;
        cs[idx] = (float)cv; sn[idx] = (float)sv;
    }
}

template <class WF>
__device__ __forceinline__ void prep_item(const WF& wf, int K, int N, int e, bf16_t* Bt, LAS float* scr, int item, int lane) {
    const int nblk = N / 32, kb = item / nblk, nb = item % nblk, k0 = 64 * kb, n0 = 32 * nb;
#pragma unroll 8
    for (int i = 0; i < 32; ++i) { const int kk = 2 * i + (lane >> 5); scr[kk * 33 + (lane & 31)] = wf(k0 + kk, n0 + (lane & 31), e); }
    LDS_WAIT(); asm volatile("" ::: "memory");
    const int c = lane & 7;
#pragma unroll
    for (int j = 0; j < 4; ++j) { const int n = (lane >> 3) + 8 * j; const LAS float* s = scr + (8 * c) * 33 + n;
        u32x4 o; o.x = pk2(s[0 * 33], s[1 * 33]); o.y = pk2(s[2 * 33], s[3 * 33]); o.z = pk2(s[4 * 33], s[5 * 33]); o.w = pk2(s[6 * 33], s[7 * 33]);
        *(u32x4*)(Bt + (size_t)(n0 + n) * K + k0 + 8 * c) = o; }
    LDS_WAIT(); asm volatile("" ::: "memory");
}
template <class WF>
__device__ __forceinline__ void prep_weight(Frame& F_, const WF& wf, int K, int N, int ne, bf16_t* Bt, size_t estride, int& itbase) {
    Frame F = F_; F.lane = lane_id_opaque(); F.tid = F.wave * 64 + F.lane;
    LAS float* scr = (LAS float*)(F.lds + RING_OFF + F.wave * 16384);
    const int gw = F.vcu * NWAVES + F.wave, NGW = F.G * NWAVES;
    const int per = (K / 64) * (N / 32), n = per * ne;
    int first = (gw - (itbase % NGW) + NGW) % NGW;
    for (int it = first; it < n; it += NGW) { const int e = it / per; prep_item(wf, K, N, e, Bt + (size_t)e * estride, scr, it % per, F.lane); }
    itbase += n;
}

__device__ __forceinline__ void conv_pass(Frame& F_, unsigned char* ws, const float* cw) {
    Frame F = F_; F.lane = lane_id_opaque(); F.tid = F.wave * 64 + F.lane;
    const int gw = F.vcu * NWAVES + F.wave, NGW = F.G * NWAVES;
    const bf16_t* z0 = (const bf16_t*)(ws + WS_Z0); bf16_t* gb = (bf16_t*)(ws + WS_GB);
    for (int it = gw; it < (M / 8) * 2; it += NGW) {
        const int t0 = (it >> 1) * 8, c0 = (it & 1) * 512 + F.lane * 8;
        float w0[8], w1[8], w2[8];
#pragma unroll
        for (int i = 0; i < 8; ++i) { w0[i] = cw[c0 + i]; w1[i] = cw[1024 + c0 + i]; w2[i] = cw[2048 + c0 + i]; }
        float zm2[8], zm1[8];
        if ((t0 % SEQ) != 0) { unpack8(*(const u32x4*)(z0 + (size_t)(t0 - 2) * 1024 + c0), zm2); unpack8(*(const u32x4*)(z0 + (size_t)(t0 - 1) * 1024 + c0), zm1); }
        else {
#pragma unroll
            for (int i = 0; i < 8; ++i) { zm2[i] = 0.f; zm1[i] = 0.f; } }
#pragma unroll
        for (int r = 0; r < 8; ++r) {
            float z[8], g[8], o[8]; unpack8(*(const u32x4*)(z0 + (size_t)(t0 + r) * 1024 + c0), z); unpack8(*(const u32x4*)(gb + (size_t)(t0 + r) * 1024 + c0), g);
#pragma unroll
            for (int i = 0; i < 8; ++i) { o[i] = g[i] * (w0[i] * zm2[i] + w1[i] * zm1[i] + w2[i] * z[i]); zm2[i] = zm1[i]; zm1[i] = z[i]; }
            *(u32x4*)(gb + (size_t)(t0 + r) * 1024 + c0) = pack8(o);
        }
    }
}

__device__ __forceinline__ void naive_attention(Frame& F_, unsigned char* ws) {
    Frame F = F_; F.lane = lane_id_opaque(); F.tid = F.wave * 64 + F.lane;
    const int gw = F.vcu * NWAVES + F.wave, NGW = F.G * NWAVES;
    const bf16_t* Q = (const bf16_t*)(ws + WS_Q); const bf16_t* K = (const bf16_t*)(ws + WS_K); const bf16_t* V = (const bf16_t*)(ws + WS_V); bf16_t* O = (bf16_t*)(ws + WS_O);
    for (int it = gw; it < NB * NH * 32; it += NGW) {
        const int ck = 31 - (it / (NB * NH)), bh = it % (NB * NH), b = bh / NH, h = bh % NH;
        const size_t row = (size_t)b * SEQ + ck * 64 + F.lane;
        float q[96];
#pragma unroll
        for (int j = 0; j < 12; ++j) unpack8(*(const u32x4*)(Q + row * 1536 + 96 * h + 8 * j), q + 8 * j);
        float o[64];
#pragma unroll
        for (int i = 0; i < 64; ++i) o[i] = 0.f;
        float mx = -INFINITY, l = 0.f;
        const int nk = (ck + 1) * 64;
        for (int j = 0; j < nk; ++j) {
            const size_t kr = (size_t)b * SEQ + j;
            float s = 0.f;
#pragma unroll
            for (int c = 0; c < 12; ++c) { float kf[8]; unpack8(*(const u32x4*)(K + kr * 1536 + 96 * h + 8 * c), kf);
#pragma unroll
                for (int i = 0; i < 8; ++i) s += q[8 * c + i] * kf[i]; }
            const float mn = fmaxf(mx, s), corr = exp2f(mx - mn), p = exp2f(s - mn);
            l = l * corr + p; mx = mn;
#pragma unroll
            for (int c = 0; c < 8; ++c) { float vf[8]; unpack8(*(const u32x4*)(V + kr * 1024 + 64 * h + 8 * c), vf);
#pragma unroll
                for (int i = 0; i < 8; ++i) o[8 * c + i] = o[8 * c + i] * corr + p * vf[i]; }
        }
        const float rl = 1.0f / l;
#pragma unroll
        for (int c = 0; c < 8; ++c) { float t[8];
#pragma unroll
            for (int i = 0; i < 8; ++i) t[i] = o[8 * c + i] * rl;
            *(u32x4*)(O + row * 1024 + 64 * h + 8 * c) = pack8(t); }
    }
}

__device__ __forceinline__ void route_pass1(Frame& F_, unsigned char* ws, const float* H, const float* gain, const float* rw) {
    Frame F = F_; F.lane = lane_id_opaque(); F.tid = F.wave * 64 + F.lane;
    const int wg = blockIdx.x, t0 = wg * 64;
    LAS int* se = (LAS int*)(F.lds + RING_OFF);
    LAS int* rk = se + 128;
    float* invf = (float*)(ws + WS_INVF); float* topw = (float*)(ws + WS_TOPW);
    for (int i = 0; i < 8; ++i) {
        const int tl = F.wave * 8 + i, t = t0 + tl;
        const f32x4* hr = (const f32x4*)(H + (size_t)t * D) + F.lane; f32x4 v[4]; float s = 0.f;
#pragma unroll
        for (int j = 0; j < 4; ++j) { v[j] = hr[64 * j]; s += (v[j][0] * v[j][0] + v[j][1] * v[j][1]) + (v[j][2] * v[j][2] + v[j][3] * v[j][3]); }
        s = wave_sum(s);
        const float inv = rsqrtf(s * (1.0f / D) + EPS);
        float lg[8];
#pragma unroll
        for (int e = 0; e < 8; ++e) lg[e] = 0.f;
#pragma unroll
        for (int j = 0; j < 4; ++j) {
            const int k = 4 * (F.lane + 64 * j);
            const f32x4 g4 = *(const f32x4*)(gain + k);
#pragma unroll
            for (int c = 0; c < 4; ++c) { const float xn = (v[j][c] * inv) * g4[c];
                const f32x4 r0 = *(const f32x4*)(rw + (size_t)(k + c) * 8), r1 = *(const f32x4*)(rw + (size_t)(k + c) * 8 + 4);
                lg[0] += xn * r0[0]; lg[1] += xn * r0[1]; lg[2] += xn * r0[2]; lg[3] += xn * r0[3]; lg[4] += xn * r1[0]; lg[5] += xn * r1[1]; lg[6] += xn * r1[2]; lg[7] += xn * r1[3]; }
        }
#pragma unroll
        for (int e = 0; e < 8; ++e) lg[e] = wave_sum(lg[e]);
        if (F.lane == 0) {
            int e0 = 0; float b0 = lg[0];
#pragma unroll
            for (int e = 1; e < 8; ++e) if (lg[e] > b0) { b0 = lg[e]; e0 = e; }
            int e1 = -1; float b1 = -INFINITY;
#pragma unroll
            for (int e = 0; e < 8; ++e) if (e != e0 && lg[e] > b1) { b1 = lg[e]; e1 = e; }
            const float w1 = 1.0f / (1.0f + __expf(b0 - b1)), w0 = 1.0f - w1;
            se[2 * tl] = e0; se[2 * tl + 1] = e1;
            invf[t] = inv; topw[2 * t] = w0; topw[2 * t + 1] = w1;
        }
    }
    LDS_WAIT(); __syncthreads();
    if (F.tid < NE) { int cnt = 0;
        for (int tl = 0; tl < 64; ++tl) { if (se[2 * tl] == F.tid) rk[2 * tl] = cnt++; if (se[2 * tl + 1] == F.tid) rk[2 * tl + 1] = cnt++; }
        ((int*)(ws + WS_WGCNT))[wg * 8 + F.tid] = cnt; }
    LDS_WAIT(); __syncthreads();
    if (F.tid < 128) { ((int*)(ws + WS_TOPE))[t0 * 2 + F.tid] = se[F.tid]; ((int*)(ws + WS_RANK))[t0 * 2 + F.tid] = rk[F.tid]; }
    LDS_WAIT(); __syncthreads();
}
__device__ __forceinline__ void route_pass2(Frame& F_, unsigned char* ws, const float* H) {
    Frame F = F_; F.lane = lane_id_opaque(); F.tid = F.wave * 64 + F.lane;
    const int wg = blockIdx.x, t0 = wg * 64;
    LAS int* cnt = (LAS int*)(F.lds + RING_OFF);
    LAS int* tot = cnt + 2048; LAS int* pre = tot + 8; LAS int* wgoff = pre + 8;
    const int* wgcnt = (const int*)(ws + WS_WGCNT);
    for (int i = F.tid; i < 2048; i += 512) cnt[i] = wgcnt[i];
    LDS_WAIT(); __syncthreads();
    if (F.tid < NE) { int tt = 0, pp = 0; for (int w = 0; w < 256; ++w) { const int c = cnt[w * 8 + F.tid]; pp += (w < wg) ? c : 0; tt += c; } tot[F.tid] = tt; pre[F.tid] = pp; }
    LDS_WAIT(); __syncthreads();
    if (F.tid == 0) { int eb = 0; for (int e = 0; e < NE; ++e) { F.MISC[16 + e] = (unsigned)(eb >> 8); wgoff[e] = eb + pre[e]; eb += (tot[e] + 255) & ~255; } F.MISC[24] = (unsigned)(eb >> 8); }
    LDS_WAIT(); __syncthreads();
    const int* tope = (const int*)(ws + WS_TOPE); const int* rank = (const int*)(ws + WS_RANK); const float* invf = (const float*)(ws + WS_INVF);
    int* slot = (int*)(ws + WS_SLOT); bf16_t* xp = (bf16_t*)(ws + WS_XP);
    for (int i = 0; i < 8; ++i) {
        const int t = t0 + F.wave * 8 + i;
        const int s0 = wgoff[tope[2 * t]] + rank[2 * t], s1 = wgoff[tope[2 * t + 1]] + rank[2 * t + 1];
        const float inv = invf[t];
        const f32x4* hr = (const f32x4*)(H + (size_t)t * D) + F.lane;
        u32x2* o0 = (u32x2*)(xp + (size_t)s0 * D) + F.lane; u32x2* o1 = (u32x2*)(xp + (size_t)s1 * D) + F.lane;
#pragma unroll
        for (int j = 0; j < 4; ++j) { const f32x4 v = hr[64 * j] * inv; u32x2 w; w.x = pk2(v[0], v[1]); w.y = pk2(v[2], v[3]); o0[64 * j] = w; o1[64 * j] = w; }
        if (F.lane == 0) { slot[2 * t] = s0; slot[2 * t + 1] = s1; }
    }
    LDS_WAIT(); __syncthreads();
}
__device__ __forceinline__ void final_pass(Frame& F_, unsigned char* ws, float* H, const float* gain) {
    Frame F = F_; F.lane = lane_id_opaque(); F.tid = F.wave * 64 + F.lane;
    const int gw = F.vcu * NWAVES + F.wave, NGW = F.G * NWAVES;
    const int* slot = (const int*)(ws + WS_SLOT); const float* topw = (const float*)(ws + WS_TOPW); const bf16_t* yp = (const bf16_t*)(ws + WS_YP);
    for (int t = gw; t < M; t += NGW) {
        const int s0 = slot[2 * t], s1 = slot[2 * t + 1]; const float w0 = topw[2 * t], w1 = topw[2 * t + 1];
        f32x4* hr = (f32x4*)(H + (size_t)t * D) + F.lane;
        const u32x2* y0 = (const u32x2*)(yp + (size_t)s0 * D) + F.lane; const u32x2* y1 = (const u32x2*)(yp + (size_t)s1 * D) + F.lane;
        f32x4 v[4]; float s = 0.f;
#pragma unroll
        for (int j = 0; j < 4; ++j) { const u32x2 a = y0[64 * j], b = y1[64 * j]; v[j] = hr[64 * j];
            v[j][0] += w0 * bflo(a.x) + w1 * bflo(b.x); v[j][1] += w0 * bfhi(a.x) + w1 * bfhi(b.x); v[j][2] += w0 * bflo(a.y) + w1 * bflo(b.y); v[j][3] += w0 * bfhi(a.y) + w1 * bfhi(b.y);
            s += (v[j][0] * v[j][0] + v[j][1] * v[j][1]) + (v[j][2] * v[j][2] + v[j][3] * v[j][3]); }
        s = wave_sum(s);
        const float inv = rsqrtf(s * (1.0f / D) + EPS);
#pragma unroll
        for (int j = 0; j < 4; ++j) { const f32x4 g4 = *((const f32x4*)gain + F.lane + 64 * j); hr[64 * j] = (v[j] * inv) * g4; }
    }
}

__device__ __forceinline__ unsigned long long karg(int idx) {
    const __attribute__((address_space(4))) unsigned long long* p = (const __attribute__((address_space(4))) unsigned long long*)__builtin_amdgcn_kernarg_segment_ptr();
    asm volatile("" : "+s"(p));
    return p[idx];
}
__device__ __forceinline__ int opq(int v) { asm volatile("" : "+s"(v)); return v; }
#define KIN(i) ((const float*)karg(i))
#define KOUT() ((float*)karg(22))
#define KWS() ((unsigned char*)karg(23))

#define GRID_BAR() xcd_barrier(bar, F.wave)
template <int l>
__device__ __forceinline__ void layer_body(Frame& F, const XcdBarrier& bar, const int cid) {
        { unsigned char* ws = KWS(); pg8::StaticOrder S; S.init(M / 256, NV1 / 256, opq(F.G), opq(cid));
          EpiProj E{ws, KIN(4) + l * 2048};
          run_gemm<FASTG(GP_PROJ), true>(F.lds, (const bf16_t*)(ws + WS_HB), (const bf16_t*)(ws + WS_MW + l * MW_LAYER + MW_WIN), 0, D, S, E, WProj{KIN(3) + (size_t)l * D * INC, KIN(2) + l * D}, F.wave); }
        GRID_BAR();
        { unsigned char* ws = KWS(); pg8::StaticOrder S; S.init(M / 256, 1536 / 256, opq(F.G), opq(cid)); EpiQ E{ws};
          run_gemm<FASTG(GP_QUP), true>(F.lds, (const bf16_t*)(ws + WS_CQ), (const bf16_t*)(ws + WS_MW + l * MW_LAYER + MW_WUQ), 0, QL, S, E, WQ{KIN(9) + (size_t)l * QL * 1536, KIN(7) + l * QL}, F.wave); }
        { unsigned char* ws = KWS(); pg8::StaticOrder S; S.init(M / 256, 2048 / 256, opq(F.G), opq(cid)); EpiKV E{ws};
          run_gemm<FASTG(GP_KVUP), true>(F.lds, (const bf16_t*)(ws + WS_CKV), (const bf16_t*)(ws + WS_MW + l * MW_LAYER + MW_WUKV), 0, KVL, S, E, WKV{KIN(10) + (size_t)l * KVL * 2048, KIN(8) + l * KVL}, F.wave); }
        conv_pass(F, KWS(), KIN(5) + l * 3 * 1024);
        GRID_BAR();
        naive_attention(F, KWS());
        GRID_BAR();
        { unsigned char* ws = KWS(); pg8::StaticOrder S; S.init(M / 256, 4, opq(F.G), opq(cid)); EpiGate<0> E{ws};
          run_gemm<FASTG(GP_CONVOUT), false>(F.lds, (const bf16_t*)(ws + WS_GB), (const bf16_t*)(ws + WS_MW + l * MW_LAYER + MW_WCO), 0, D, S, E, WPlain{KIN(6) + (size_t)l * D * D, D, 0}, F.wave); }
        VM_WAIT(); __syncthreads();
        { unsigned char* ws = KWS(); pg8::StaticOrder S; S.init(M / 256, 4, opq(F.G), opq(cid)); EpiGate<1> E{ws};
          run_gemm<FASTG(GP_ATTNOUT), false>(F.lds, (const bf16_t*)(ws + WS_O), (const bf16_t*)(ws + WS_MW + l * MW_LAYER + MW_WAO), 0, D, S, E, WPlain{KIN(11) + (size_t)l * D * D, D, 0}, F.wave); }
        GRID_BAR();
        { unsigned char* ws = KWS(); pg8::StaticOrder S; S.init(M / 256, 4, opq(F.G), opq(cid)); EpiResid E{l == 0 ? KIN(0) : (const float*)KOUT(), KOUT(), ws};
          run_gemm<FASTG(GP_MIXOUT), false>(F.lds, (const bf16_t*)(ws + WS_MX), (const bf16_t*)(ws + WS_MW + l * MW_LAYER + MW_WMX), 0, D, S, E, WPlain{KIN(12) + (size_t)l * D * D, D, 0}, F.wave); }
        GRID_BAR();
        if (l == 0) {
            { unsigned char* ws = KWS(); pg8::StaticOrder S; S.init(M / 256, 22, opq(F.G), opq(cid)); EpiSwiglu E{(const float*)(ws + WS_SSQH), (bf16_t*)(ws + WS_ACT), FFD};
              run_gemm<FASTG(GP_FFUP), true>(F.lds, (const bf16_t*)(ws + WS_HB), (const bf16_t*)(ws + WS_WGU), 0, D, S, E, WGU{KIN(14), KIN(15), KIN(13) + l * D, FFD, 0}, F.wave); }
            GRID_BAR();
            { unsigned char* ws = KWS(); pg8::StaticOrder S; S.init(M / 256, 4, opq(F.G), opq(cid)); EpiResid E{KOUT(), KOUT(), ws};
              run_gemm<FASTG(GP_FFDOWN), false>(F.lds, (const bf16_t*)(ws + WS_ACT), (const bf16_t*)(ws + WS_WD), 0, FFD, S, E, WPlain{KIN(16), D, 0}, F.wave); }
            GRID_BAR();
        } else {
            route_pass1(F, KWS(), KOUT(), KIN(13) + l * D, KIN(17));
            { int itb = 0; if (FASTG(GP_MOEUP)) prep_weight(F, WGU{KIN(18), KIN(19), KIN(13) + l * D, FFE, (size_t)D * FFE}, D, 2 * FFE, NE, (bf16_t*)(KWS() + WS_WGUE), (size_t)3584 * D, itb); }
            GRID_BAR();
            route_pass2(F, KWS(), KOUT());
            { int itb = 0; if (FASTG(GP_MOEDOWN)) prep_weight(F, WPlain{KIN(20), D, (size_t)FFE * D}, FFE, D, NE, (bf16_t*)(KWS() + WS_WDE), (size_t)D * FFE, itb); }
            GRID_BAR();
            { unsigned char* ws = KWS(); pg8::StaticOrder S; S.init((int)F.MISC[24], 14, opq(F.G), opq(cid), F.MISC + 16); EpiSwiglu E{nullptr, (bf16_t*)(ws + WS_ACTE), FFE};
              run_gemm<FASTG(GP_MOEUP), true>(F.lds, (const bf16_t*)(ws + WS_XP), (const bf16_t*)(ws + WS_WGUE), (size_t)3584 * D, D, S, E, WGU{KIN(18), KIN(19), KIN(13) + l * D, FFE, (size_t)D * FFE}, F.wave); }
            GRID_BAR();
            { unsigned char* ws = KWS(); pg8::StaticOrder S; S.init((int)F.MISC[24], 4, opq(F.G), opq(cid), F.MISC + 16); EpiStore E{(bf16_t*)(ws + WS_YP), D};
              run_gemm<FASTG(GP_MOEDOWN), true>(F.lds, (const bf16_t*)(ws + WS_ACTE), (const bf16_t*)(ws + WS_WDE), (size_t)D * FFE, FFE, S, E, WPlain{KIN(20), D, (size_t)FFE * D}, F.wave); }
            GRID_BAR();
            final_pass(F, KWS(), KOUT(), KIN(21));
        }
}

__global__ void __launch_bounds__(NWAVES * 64, 2) mk_fwd(Args args) {
    extern __shared__ __attribute__((aligned(16))) unsigned char lds[];
    Frame F;
    F.lds = (LAS unsigned char*)lds; F.MISC = (volatile LAS unsigned*)(F.lds + MISC_OFF);
    F.tid = threadIdx.x; F.lane = F.tid & 63; F.wave = __builtin_amdgcn_readfirstlane((int)threadIdx.x >> 6);
    F.G = gridDim.x; { const int bx = blockIdx.x; F.vcu = (F.G % 8 == 0) ? (bx % 8) * (F.G / 8) + bx / 8 : bx; }
    for (int u = F.tid; u < (LDS_BYTES - LDSCTL_OFF) / 4; u += NWAVES * 64) ((LAS unsigned*)(F.lds + LDSCTL_OFF))[u] = 0u;
    __syncthreads();
    XcdBarrier bar = xcd_barrier_post((unsigned*)(args.ws + WS_CTL) + CW_BAR, F.MISC + 8);
    const int cid = (int)blockIdx.x;

    p0_rows(F, KWS(), KIN(0), (const int*)KIN(1));
    { int itb = 0;
#pragma unroll 1
      for (int l = 0; l < 2; ++l) {
        bf16_t* mw = (bf16_t*)(KWS() + WS_MW + l * MW_LAYER);
        if (FASTG(GP_PROJ)) prep_weight(F, WProj{KIN(3) + (size_t)l * D * INC, KIN(2) + l * D}, D, NV1, 1, mw + MW_WIN / 2, 0, itb);
        if (FASTG(GP_CONVOUT)) prep_weight(F, WPlain{KIN(6) + (size_t)l * D * D, D, 0}, D, D, 1, mw + MW_WCO / 2, 0, itb);
        if (FASTG(GP_ATTNOUT)) prep_weight(F, WPlain{KIN(11) + (size_t)l * D * D, D, 0}, D, D, 1, mw + MW_WAO / 2, 0, itb);
        if (FASTG(GP_MIXOUT)) prep_weight(F, WPlain{KIN(12) + (size_t)l * D * D, D, 0}, D, D, 1, mw + MW_WMX / 2, 0, itb);
        if (FASTG(GP_QUP)) prep_weight(F, WQ{KIN(9) + (size_t)l * QL * 1536, KIN(7) + l * QL}, QL, 1536, 1, mw + MW_WUQ / 2, 0, itb);
        if (FASTG(GP_KVUP)) prep_weight(F, WKV{KIN(10) + (size_t)l * KVL * 2048, KIN(8) + l * KVL}, KVL, 2048, 1, mw + MW_WUKV / 2, 0, itb);
      }
      if (FASTG(GP_FFUP)) prep_weight(F, WGU{KIN(14), KIN(15), KIN(13), FFD, 0}, D, 2 * FFD, 1, (bf16_t*)(KWS() + WS_WGU), 0, itb);
      if (FASTG(GP_FFDOWN)) prep_weight(F, WPlain{KIN(16), D, 0}, FFD, D, 1, (bf16_t*)(KWS() + WS_WD), 0, itb);
    }
    GRID_BAR();

    layer_body<0>(F, bar, cid);
    layer_body<1>(F, bar, cid);
}

extern "C" void kernel_launch(void* const* d_in, const int* in_sizes, int n_in, void* d_out, int out_size, void* d_ws, size_t ws_size, hipStream_t stream) {
    static int grid = 0;
    if (grid == 0) {
        if (n_in != 22 || in_sizes[0] != M * D || out_size != M * D || ws_size < WS_END) { fprintf(stderr, "kernel_launch: unexpected shapes (n_in %d, out %d, ws %zu < %zu)\n", n_in, out_size, ws_size, (size_t)WS_END); grid = -1; return; }
        int dev = 0, cus = 0;
        if (hipGetDevice(&dev) != hipSuccess || hipDeviceGetAttribute(&cus, hipDeviceAttributeMultiprocessorCount, dev) != hipSuccess) { grid = -1; return; }
        if (hipFuncSetAttribute((const void*)mk_fwd, hipFuncAttributeMaxDynamicSharedMemorySize, LDS_BYTES) != hipSuccess) { fprintf(stderr, "kernel_launch: hipFuncSetAttribute failed\n"); grid = -1; return; }
        (void)hipGetLastError();
        grid = cus;
        if (grid != 256) { fprintf(stderr, "kernel_launch: built for 256 CUs, found %d\n", cus); grid = -1; return; }
    }
    if (grid < 0) return;
    (void)hipMemsetAsync((char*)d_ws + WS_CTL, 0, CTL_ZERO_BYTES, stream);
    Args a{};
    for (int i = 0; i < 22; ++i) a.in[i] = (const float*)d_in[i];
    a.out = (float*)d_out; a.ws = (unsigned char*)d_ws;
    hipLaunchKernelGGL(mk_fwd, dim3(grid), dim3(NWAVES * 64), LDS_BYTES, stream, a);
}
```

```cpp
#include <hip/hip_runtime.h>
#include <cstdio>
#include <cstdint>

#ifndef FAST_GEMM_MASK
#define FAST_GEMM_MASK 0x3ffu
#endif
#ifndef FAST_ATTN
#define FAST_ATTN 1
#endif
enum { GP_PROJ = 0, GP_QUP = 1, GP_KVUP = 2, GP_CONVOUT = 3, GP_ATTNOUT = 4, GP_MIXOUT = 5, GP_FFUP = 6, GP_FFDOWN = 7, GP_MOEUP = 8, GP_MOEDOWN = 9 };
#define FASTG(i) (((FAST_GEMM_MASK) >> (i)) & 1u)

constexpr int M = 16384, D = 1024, SEQ = 2048, NB = 8, NH = 16, QKD = 96, VD = 64, QL = 256, KVL = 128;
constexpr int INC = 5536, NV1 = 5632;
constexpr int FFD = 2816, NE = 8, FFE = 1792;
constexpr int SPMAX = 34816;
constexpr float EPS = 1e-6f;
constexpr float C2 = 0.14724444602590306f;
constexpr int NWAVES = 8;

#define GAS __attribute__((address_space(1)))
#define LAS __attribute__((address_space(3)))
typedef unsigned short bf16_t;
typedef short bf16x8 __attribute__((ext_vector_type(8)));
typedef float f32x4 __attribute__((ext_vector_type(4)));
typedef float f32x2 __attribute__((ext_vector_type(2)));
typedef unsigned u32x4 __attribute__((ext_vector_type(4)));
typedef unsigned u32x2 __attribute__((ext_vector_type(2)));
typedef int i32x2 __attribute__((ext_vector_type(2)));
typedef __bf16 bf16x2_t __attribute__((ext_vector_type(2)));
typedef GAS unsigned gu32;

__device__ __forceinline__ unsigned pk2(float lo, float hi) { f32x2 v = {lo, hi}; bf16x2_t b = __builtin_convertvector(v, bf16x2_t); return __builtin_bit_cast(unsigned, b); }
__device__ __forceinline__ float bflo(unsigned u) { return __uint_as_float(u << 16); }
__device__ __forceinline__ float bfhi(unsigned u) { return __uint_as_float(u & 0xffff0000u); }
__device__ __forceinline__ float bf2f(bf16_t b) { return __uint_as_float((unsigned)b << 16); }
__device__ __forceinline__ u32x4 pack8(const float* v) { u32x4 w; w.x = pk2(v[0], v[1]); w.y = pk2(v[2], v[3]); w.z = pk2(v[4], v[5]); w.w = pk2(v[6], v[7]); return w; }
__device__ __forceinline__ void unpack8(u32x4 w, float* v) { v[0] = bflo(w.x); v[1] = bfhi(w.x); v[2] = bflo(w.y); v[3] = bfhi(w.y); v[4] = bflo(w.z); v[5] = bfhi(w.z); v[6] = bflo(w.w); v[7] = bfhi(w.w); }
__device__ __forceinline__ float sigmoidf_(float x) { return 1.0f / (1.0f + __expf(-x)); }
__device__ __forceinline__ float wave_sum(float v) {
#pragma unroll
    for (int o = 1; o < 64; o <<= 1) v += __shfl_xor(v, o);
    return v;
}
__device__ __forceinline__ int lane_id_opaque() { int l; asm volatile("v_mbcnt_lo_u32_b32 %0, -1, 0\n\tv_mbcnt_hi_u32_b32 %0, -1, %0" : "=v"(l)); return l; }
#define LDS_WAIT() asm volatile("s_waitcnt lgkmcnt(0)" ::: "memory")
#define VM_WAIT() asm volatile("s_waitcnt vmcnt(0)" ::: "memory")

constexpr size_t MiB = 1u << 20;
constexpr size_t WS_CTL = 0, CTL_ZERO_BYTES = 64 * 1024;
constexpr size_t WS_COS = 1 * MiB, WS_SIN = 2 * MiB;
constexpr size_t WS_SSQH = 3 * MiB;
constexpr size_t WS_SSQQ = 4 * MiB, WS_SSQKV = WS_SSQQ + 256 * 1024;
constexpr size_t WS_TOPE = WS_SSQKV + 256 * 1024;
constexpr size_t WS_TOPW = WS_TOPE + 128 * 1024;
constexpr size_t WS_RANK = WS_TOPW + 128 * 1024;
constexpr size_t WS_SLOT = WS_RANK + 128 * 1024;
constexpr size_t WS_INVF = WS_SLOT + 128 * 1024;
constexpr size_t WS_WGCNT = WS_INVF + 64 * 1024;
static_assert(WS_WGCNT + 8192 <= 6 * MiB, "small tables");
constexpr size_t WS_HB = 6 * MiB;
constexpr size_t WS_V = WS_HB;
constexpr size_t WS_MW = 38 * MiB, MW_LAYER = 18 * MiB + 512 * 1024;
constexpr size_t MW_WIN = 0, MW_WCO = 11 * MiB, MW_WAO = 13 * MiB, MW_WMX = 15 * MiB, MW_WUQ = 17 * MiB, MW_WUKV = 17 * MiB + 768 * 1024;
constexpr size_t WS_WGU = 75 * MiB, WS_WD = 86 * MiB;
constexpr size_t WS_Z0 = 92 * MiB, WS_GB = 124 * MiB, WS_CQ = 156 * MiB, WS_CKV = 164 * MiB, WS_G = 168 * MiB, WS_Q = 232 * MiB, WS_K = 280 * MiB;
constexpr size_t WS_O = WS_Z0, WS_MX = WS_Q, WS_ACT = 92 * MiB;
constexpr size_t WS_WGUE = 38 * MiB, WS_WDE = 94 * MiB, WS_XP = 122 * MiB, WS_YP = WS_XP, WS_ACTE = 190 * MiB;
constexpr size_t WS_END = 328 * MiB;
static_assert(WS_K + (size_t)M * 1536 * 2 <= WS_END && WS_ACTE + (size_t)SPMAX * FFE * 2 <= WS_END && WS_ACT + (size_t)M * FFD * 2 <= WS_Q, "ws map");
static_assert(WS_WGUE + (size_t)NE * 3584 * 1024 * 2 <= WS_WDE && WS_WDE + (size_t)NE * 1024 * FFE * 2 <= WS_XP && WS_XP + (size_t)SPMAX * 1024 * 2 <= WS_ACTE, "moe map");
constexpr int CW_TMO = 0, CW_BAR = 1024;

constexpr int RING_OFF = 0, RING_BYTES = 131072;
constexpr int LDSCTL_OFF = RING_BYTES, MISC_OFF = LDSCTL_OFF + 320;
constexpr int LDS_BYTES = 147456;

__device__ __forceinline__ int vmap_in(int v) {
    const int t = v >> 8, j = v & 255;
    if (t < 8) return (j < 128) ? (1024 + 128 * t + j) : (2048 + 128 * t + (j - 128));
    if (t < 12) return 256 * (t - 8) + j;
    if (t == 12) return 3072 + j;
    if (t == 13) { if (j < 128) return 3328 + j; if (j < 160) { const int p = (j - 128) >> 1, odd = (j - 128) & 1; return 3456 + p + 16 * odd; } return -1; }
    return 3488 + 256 * (t - 14) + j;
}
__device__ __forceinline__ int vmap_q(int v) { const int h = v / 96, d = v % 96; if (d < 64) return v; const int p = (d - 64) >> 1, odd = (d - 64) & 1; return 96 * h + 64 + p + 16 * odd; }

struct WProj { const float* w; const float* gain; __device__ __forceinline__ float operator()(int k, int v, int) const { const int o = vmap_in(v); return o < 0 ? 0.f : gain[k] * w[(size_t)k * INC + o]; } };
struct WQ { const float* w; const float* gain; __device__ __forceinline__ float operator()(int k, int v, int) const { return gain[k] * w[(size_t)k * 1536 + vmap_q(v)]; } };
struct WKV { const float* w; const float* gain; __device__ __forceinline__ float operator()(int k, int v, int) const { return gain[k] * w[(size_t)k * 2048 + v]; } };
struct WPlain { const float* w; int ldn; size_t estride; __device__ __forceinline__ float operator()(int k, int v, int e) const { return w[(size_t)e * estride + (size_t)k * ldn + v]; } };
struct WGU { const float* wg; const float* wu; const float* gain; int ff; size_t estride;
    __device__ __forceinline__ float operator()(int k, int v, int e) const { const int t = v >> 8, j = v & 255; const size_t o = (size_t)e * estride + (size_t)k * ff + 128 * t + (j & 127);
        const size_t delta = (size_t)((const char*)wu - (const char*)wg);
        const float* p = (const float*)((const char*)wg + ((j >= 128) ? delta : (size_t)0)); return gain[k] * p[o]; } };

namespace pg8 {
constexpr int BM = 256, BK = 64, HALF = 128, HTB = HALF * BK * 2, STAGE_BYTES = 8 * HTB, NXCD = 8, WGM = 8;
__device__ __forceinline__ int lds_byte(int r, int c) { const int st = (r >> 4) * 2 + (c >> 5), rr = r & 15, cc = c & 31, ob = rr * 64 + cc * 2; return st * 1024 + (ob ^ (((ob >> 9) & 1) << 5)); }
__device__ __forceinline__ void stage_rc(int b, int& R, int& C) { const int st = b / 1024, sb = b % 1024, swz = sb ^ (((sb >> 9) & 1) << 5); R = (st >> 1) * 16 + swz / 64; C = (st & 1) * 32 + (swz % 64) / 2; }
__device__ __forceinline__ int perm32(int rho) { const int n = rho >> 4, i = rho & 15; return 8 * (i >> 2) + 4 * n + (i & 3); }

struct Unit { int pm, pn, e; };
struct Gemm { const bf16_t* A; const bf16_t* Bt; int K; size_t estride; };

struct StaticOrder {
    int nM, nN, nwg, G, c; const volatile LAS unsigned* ebt;
    __device__ void init(int nM_, int nN_, int G_, int c_, const volatile LAS unsigned* ebt_ = nullptr) { nM = nM_; nN = nN_; nwg = nM * nN; G = G_; c = c_; ebt = ebt_; }
    __device__ bool next(int i, Unit& u) const {
        const long L = (long)i * G + c; if (L >= nwg) return false;
        int wgid = (int)L; { const int q = nwg / NXCD, r = nwg % NXCD, xcd = wgid % NXCD, off = wgid / NXCD; wgid = (xcd < r ? xcd * (q + 1) : r * (q + 1) + (xcd - r) * q) + off; }
        const int nig = WGM * nN, gid = wgid / nig, fm = gid * WGM, gsz = (nM - fm) < WGM ? (nM - fm) : WGM;
        u.pm = fm + ((wgid % nig) % gsz); u.pn = (wgid % nig) / gsz; u.e = 0;
        if (ebt) { int e = 0;
#pragma unroll
            for (int j = 1; j < NE; ++j) e += ((int)ebt[j] <= u.pm) ? 1 : 0;
            u.e = e; }
        return true;
    }
};
typedef f32x4 f32x4_;
template <class Epi, class Sched, bool ALIGN_EPI = false, bool SP2 = false>
__device__ __forceinline__ void gemm_phase(LAS unsigned char* lds, const Gemm g, const Sched& S, const Epi& E, int wave_) {
    const int lane = lane_id_opaque(), wid = wave_, tid = wid * 64 + lane, wr = wid >> 2, wc = wid & 3, fr = lane & 15, fq = lane >> 4;
    const int K = g.K, nt = K / BK;
    unsigned voffA[2], voffB[2];
#pragma unroll
    for (int i = 0; i < 2; ++i) { int R, C; stage_rc(tid * 16 + i * 8192, R, C); const int Rb = Epi::PERM ? ((R & ~31) + perm32(R & 31)) : R;
        voffA[i] = (unsigned)(R * K + C) * 2u; voffB[i] = (unsigned)(Rb * K + C) * 2u; }
    const size_t kstep = (size_t)(BK * 2);
    const size_t hstep = (size_t)HALF * K * 2;
    const size_t tstep = 2 * hstep;
    const unsigned ldsw = (unsigned)wid * 1024u;
    const int aoff = lds_byte(wr * 64 + fr, fq * 8), boff = lds_byte(wc * 32 + fr, fq * 8);
#define PG8_SA(b, h) (((b) * 2 + (h)) * HTB)
#define PG8_SB(b, h) ((4 + (b) * 2 + (h)) * HTB)
#define PG8_STAGE(bufoff, gbase, voff) do { _Pragma("unroll") for (int _i = 0; _i < 2; ++_i) \
        __builtin_amdgcn_global_load_lds((const unsigned*)((const char*)(gbase) + (voff)[_i]), (LAS unsigned*)(lds + (bufoff) + ldsw + _i * 8192), 16, 0, 0); } while (0)
#define PG8_LDA(dst, b, h) do { _Pragma("unroll") for (int m = 0; m < 4; ++m) _Pragma("unroll") for (int k = 0; k < 2; ++k) dst[m][k] = *(const LAS bf16x8*)(lds + PG8_SA(b, h) + aoff + m * 2048 + k * 1024); } while (0)
#define PG8_LDB(dst, b, h) do { _Pragma("unroll") for (int n = 0; n < 2; ++n) _Pragma("unroll") for (int k = 0; k < 2; ++k) dst[n][k] = *(const LAS bf16x8*)(lds + PG8_SB(b, h) + boff + n * 2048 + k * 1024); } while (0)
#define PG8_MMA(ai, bj, At, Bt) do { __builtin_amdgcn_s_setprio(1); _Pragma("unroll") for (int m = 0; m < 4; ++m) _Pragma("unroll") for (int n = 0; n < 2; ++n) _Pragma("unroll") for (int k = 0; k < 2; ++k) \
        acc[ai][bj][m][n] = __builtin_amdgcn_mfma_f32_16x16x32_bf16(Bt[n][k], At[m][k], acc[ai][bj][m][n], 0, 0, 0); __builtin_amdgcn_s_setprio(0); } while (0)
#define PG8_WAIT_V(n) asm volatile("s_waitcnt vmcnt(" #n ")" ::: "memory")
#define PG8_WAIT_L(n) asm volatile("s_waitcnt lgkmcnt(" #n ")" ::: "memory")
#define PG8_BAR __builtin_amdgcn_s_barrier()
#define PG8_SCHED __builtin_amdgcn_sched_barrier(0)
    Unit cur, nxt; int ui = 0;
    if (!S.next(0, cur)) return;
    f32x4 acc[2][2][4][2];
#pragma unroll
    for (int a = 0; a < 2; ++a)
#pragma unroll
        for (int b = 0; b < 2; ++b)
#pragma unroll
            for (int m = 0; m < 4; ++m)
#pragma unroll
                for (int n = 0; n < 2; ++n) acc[a][b][m][n] = (f32x4){0.f, 0.f, 0.f, 0.f};
    bf16x8 At[4][2], B0[2][2], B1[2][2];
    const char* cA = (const char*)g.A + (size_t)cur.pm * tstep; const char* cB = (const char*)g.Bt + (size_t)cur.e * g.estride * 2 + (size_t)cur.pn * tstep;
    if constexpr (SP2) {
        PG8_STAGE(PG8_SB(0, 0), cB, voffB); PG8_STAGE(PG8_SB(0, 1), cB + hstep, voffB); PG8_STAGE(PG8_SA(0, 0), cA, voffA); PG8_STAGE(PG8_SA(0, 1), cA + hstep, voffA);
        if (wr == 1) PG8_BAR;
        PG8_WAIT_V(2); PG8_BAR;
        PG8_STAGE(PG8_SB(1, 0), cB + kstep, voffB); PG8_STAGE(PG8_SA(1, 0), cA + kstep, voffA); PG8_STAGE(PG8_SB(1, 1), cB + hstep + kstep, voffB);
        PG8_WAIT_V(6); PG8_BAR;
    } else {
        PG8_STAGE(PG8_SB(0, 0), cB, voffB); PG8_STAGE(PG8_SA(0, 0), cA, voffA); PG8_STAGE(PG8_SB(0, 1), cB + hstep, voffB); PG8_STAGE(PG8_SA(0, 1), cA + hstep, voffA);
        if (wr == 1) PG8_BAR;
        PG8_WAIT_V(4); PG8_BAR;
        PG8_STAGE(PG8_SB(1, 0), cB + kstep, voffB); PG8_STAGE(PG8_SA(1, 0), cA + kstep, voffA); PG8_STAGE(PG8_SB(1, 1), cB + hstep + kstep, voffB);
        PG8_WAIT_V(6); PG8_BAR;
    }
    for (;;) {
        const bool has_next = S.next(ui + 1, nxt);
        const char* nA = has_next ? (const char*)g.A + (size_t)nxt.pm * tstep : cA; const char* nB = has_next ? (const char*)g.Bt + (size_t)nxt.e * g.estride * 2 + (size_t)nxt.pn * tstep : cB;
        for (int t = 0; t < nt; t += 2) {
            const bool last = (t == nt - 2);
            const char* a1 = cA + (size_t)(t + 1) * kstep;
            const char* a2 = last ? nA : cA + (size_t)(t + 2) * kstep; const char* b2 = last ? nB : cB + (size_t)(t + 2) * kstep;
            const char* a3 = a2 + kstep; const char* b3 = b2 + kstep;
            if constexpr (SP2) {
            PG8_LDB(B0, 0, 0); PG8_LDB(B1, 0, 1); PG8_SCHED; PG8_LDA(At, 0, 0); PG8_STAGE(PG8_SA(1, 1), a1 + hstep, voffA);
            PG8_WAIT_V(8); PG8_WAIT_L(0); PG8_BAR; PG8_MMA(0, 0, At, B0); PG8_MMA(0, 1, At, B1); PG8_BAR; PG8_SCHED;
            PG8_LDA(At, 0, 1); PG8_STAGE(PG8_SB(0, 0), b2, voffB); PG8_STAGE(PG8_SB(0, 1), b2 + hstep, voffB); PG8_STAGE(PG8_SA(0, 0), a2, voffA);
            PG8_WAIT_V(8); PG8_WAIT_L(0); PG8_BAR; PG8_MMA(1, 0, At, B0); PG8_MMA(1, 1, At, B1); PG8_BAR; PG8_SCHED;
            PG8_LDB(B0, 1, 0); PG8_LDB(B1, 1, 1); PG8_SCHED; PG8_LDA(At, 1, 0); PG8_STAGE(PG8_SA(0, 1), a2 + hstep, voffA);
            PG8_WAIT_V(8); PG8_WAIT_L(0); PG8_BAR; PG8_MMA(0, 0, At, B0); PG8_MMA(0, 1, At, B1); PG8_BAR; PG8_SCHED;
            PG8_LDA(At, 1, 1); PG8_STAGE(PG8_SB(1, 0), b3, voffB); PG8_STAGE(PG8_SB(1, 1), b3 + hstep, voffB); PG8_STAGE(PG8_SA(1, 0), a3, voffA);
            PG8_WAIT_V(8); PG8_WAIT_L(0); PG8_BAR; PG8_MMA(1, 0, At, B0); PG8_MMA(1, 1, At, B1); PG8_BAR; PG8_SCHED;
            } else {
            PG8_LDB(B0, 0, 0); PG8_SCHED; PG8_LDA(At, 0, 0); PG8_STAGE(PG8_SA(1, 1), a1 + hstep, voffA);
            PG8_WAIT_L(8); PG8_BAR; PG8_WAIT_L(0); PG8_MMA(0, 0, At, B0); PG8_BAR; PG8_SCHED;
            PG8_LDB(B1, 0, 1); PG8_STAGE(PG8_SB(0, 0), b2, voffB);
            PG8_BAR; PG8_WAIT_L(0); PG8_MMA(0, 1, At, B1); PG8_BAR;
            PG8_LDA(At, 0, 1); PG8_STAGE(PG8_SA(0, 0), a2, voffA);
            PG8_BAR; PG8_WAIT_L(0); PG8_MMA(1, 0, At, B0); PG8_BAR; PG8_SCHED;
            PG8_STAGE(PG8_SB(0, 1), b2 + hstep, voffB);
            PG8_WAIT_V(6); PG8_BAR; PG8_MMA(1, 1, At, B1); PG8_BAR;
            PG8_LDB(B0, 1, 0); PG8_SCHED; PG8_LDA(At, 1, 0); PG8_STAGE(PG8_SA(0, 1), a2 + hstep, voffA);
            PG8_WAIT_L(8); PG8_BAR; PG8_WAIT_L(0); PG8_MMA(0, 0, At, B0); PG8_BAR; PG8_SCHED;
            PG8_LDB(B1, 1, 1); PG8_STAGE(PG8_SB(1, 0), b3, voffB);
            PG8_BAR; PG8_WAIT_L(0); PG8_MMA(0, 1, At, B1); PG8_BAR;
            PG8_LDA(At, 1, 1); PG8_STAGE(PG8_SA(1, 0), a3, voffA);
            PG8_BAR; PG8_WAIT_L(0); PG8_MMA(1, 0, At, B0); PG8_BAR; PG8_SCHED;
            PG8_STAGE(PG8_SB(1, 1), b3 + hstep, voffB);
            PG8_WAIT_V(6); PG8_BAR; PG8_MMA(1, 1, At, B1); PG8_BAR;
            }
        }
        if constexpr (ALIGN_EPI) { if (wr == 0) PG8_BAR; }
        if constexpr (!Epi::AFTER_DRAIN) { E(acc, cur, wr, wc, fr, fq); }
        if (!has_next) break;
#pragma unroll
        for (int a = 0; a < 2; ++a)
#pragma unroll
            for (int b = 0; b < 2; ++b)
#pragma unroll
                for (int m = 0; m < 4; ++m)
#pragma unroll
                    for (int n = 0; n < 2; ++n) acc[a][b][m][n] = (f32x4){0.f, 0.f, 0.f, 0.f};
        cur = nxt; cA = nA; cB = nB; ++ui;
        if constexpr (ALIGN_EPI) { if (wr == 1) PG8_BAR; }
    }
    PG8_WAIT_V(0);
    if constexpr (!ALIGN_EPI) { if (wr == 0) PG8_BAR; }
    PG8_BAR;
    if constexpr (Epi::AFTER_DRAIN) { E.fused(acc, cur, wr, wc, fr, fq, lds, wid, lane); }
#undef PG8_SA
#undef PG8_SB
#undef PG8_STAGE
#undef PG8_LDA
#undef PG8_LDB
#undef PG8_MMA
#undef PG8_WAIT_V
#undef PG8_WAIT_L
#undef PG8_BAR
#undef PG8_SCHED
}
}
using pg8::Unit;
typedef f32x4 Acc[2][2][4][2];

#define EPI_ROW(ai, m) (u.pm * 256 + (ai) * 128 + wr * 64 + (m) * 16 + fr)
#define EPI_GET8(dst, ai, bj, m, sc) do { const f32x4 _a = acc[ai][bj][m][0], _b = acc[ai][bj][m][1]; dst[0] = _a[0] * (sc); dst[1] = _a[1] * (sc); dst[2] = _a[2] * (sc); dst[3] = _a[3] * (sc); \
        dst[4] = _b[0] * (sc); dst[5] = _b[1] * (sc); dst[6] = _b[2] * (sc); dst[7] = _b[3] * (sc); } while (0)
__device__ __forceinline__ float sum16(const float* p) { const f32x4 a = *(const f32x4*)p, b = *(const f32x4*)(p + 4), c = *(const f32x4*)(p + 8), d = *(const f32x4*)(p + 12);
    return ((a[0] + a[1]) + (a[2] + a[3])) + ((b[0] + b[1]) + (b[2] + b[3])) + ((c[0] + c[1]) + (c[2] + c[3])) + ((d[0] + d[1]) + (d[2] + d[3])); }
__device__ __forceinline__ float sum4(const float* p) { const f32x4 a = *(const f32x4*)p; return (a[0] + a[1]) + (a[2] + a[3]); }
__device__ __forceinline__ float sumsq8(const float* v) { return ((v[0] * v[0] + v[1] * v[1]) + (v[2] * v[2] + v[3] * v[3])) + ((v[4] * v[4] + v[5] * v[5]) + (v[6] * v[6] + v[7] * v[7])); }

struct EpiProj {
    static constexpr bool PERM = true, AFTER_DRAIN = false;
    unsigned char* ws; const float* bgate;
    __device__ __forceinline__ void operator()(const Acc& acc, const Unit& u, int wr, int wc, int fr, int fq) const {
        const int cb = wc * 32 + 8 * fq, pn = u.pn;
        const float* ssqh = (const float*)(ws + WS_SSQH);
#define PROJ_ROWS_BEGIN _Pragma("unroll") for (int ai = 0; ai < 2; ++ai) _Pragma("unroll") for (int m = 0; m < 4; ++m) { const int row = EPI_ROW(ai, m); \
            const float inv = rsqrtf(sum16(ssqh + (size_t)row * 16) * (1.0f / D) + EPS); float v0[8], v1[8]; EPI_GET8(v0, ai, 0, m, inv); EPI_GET8(v1, ai, 1, m, inv);
#define PROJ_ROWS_END }
        if (pn < 8) {
            bf16_t* z0 = (bf16_t*)(ws + WS_Z0);
            PROJ_ROWS_BEGIN
                float z[8];
#pragma unroll
                for (int i = 0; i < 8; ++i) z[i] = v0[i] * v1[i];
                *(u32x4*)(z0 + (size_t)row * 1024 + 128 * pn + cb) = pack8(z);
            PROJ_ROWS_END
        } else if (pn < 12) {
            bf16_t* gb = (bf16_t*)(ws + WS_GB);
            PROJ_ROWS_BEGIN
                bf16_t* p = gb + (size_t)row * 1024 + 256 * (pn - 8) + cb;
                *(u32x4*)p = pack8(v0); *(u32x4*)(p + 128) = pack8(v1);
            PROJ_ROWS_END
        } else if (pn == 12) {
            bf16_t* cq = (bf16_t*)(ws + WS_CQ); float* ssqq = (float*)(ws + WS_SSQQ);
            PROJ_ROWS_BEGIN
                bf16_t* p = cq + (size_t)row * 256 + cb;
                *(u32x4*)p = pack8(v0); *(u32x4*)(p + 128) = pack8(v1);
                float s = sumsq8(v0) + sumsq8(v1); s += __shfl_xor(s, 16); s += __shfl_xor(s, 32);
                if (fq == 0) ssqq[(size_t)row * 4 + wc] = s;
            PROJ_ROWS_END
        } else if (pn == 13) {
            bf16_t* ckv = (bf16_t*)(ws + WS_CKV); float* ssqkv = (float*)(ws + WS_SSQKV); bf16_t* kk = (bf16_t*)(ws + WS_K);
            const float* cs = (const float*)(ws + WS_COS); const float* sn = (const float*)(ws + WS_SIN);
            PROJ_ROWS_BEGIN
                *(u32x4*)(ckv + (size_t)row * 128 + cb) = pack8(v0);
                float s = sumsq8(v0); s += __shfl_xor(s, 16); s += __shfl_xor(s, 32);
                if (fq == 0) ssqkv[(size_t)row * 4 + wc] = s;
                if (wc == 0) {
                    const f32x4 c4 = *(const f32x4*)(cs + (size_t)row * 16 + 4 * fq), s4 = *(const f32x4*)(sn + (size_t)row * 16 + 4 * fq);
                    float r[8];
#pragma unroll
                    for (int j = 0; j < 4; ++j) { const float t1 = v1[2 * j], t2 = v1[2 * j + 1]; r[2 * j] = t1 * c4[j] - t2 * s4[j]; r[2 * j + 1] = t1 * s4[j] + t2 * c4[j]; }
                    const u32x4 w = pack8(r);
                    bf16_t* kp = kk + (size_t)row * 1536 + 64 + 8 * fq;
#pragma unroll
                    for (int h = 0; h < NH; ++h) *(u32x4*)(kp + 96 * h) = w;
                }
            PROJ_ROWS_END
        } else {
            bf16_t* g = (bf16_t*)(ws + WS_G);
            const int c = 256 * (pn - 14) + cb;
            const f32x4 b0 = *(const f32x4*)(bgate + c), b1 = *(const f32x4*)(bgate + c + 4), b2 = *(const f32x4*)(bgate + c + 128), b3 = *(const f32x4*)(bgate + c + 132);
            PROJ_ROWS_BEGIN
                float g0[8], g1[8];
#pragma unroll
                for (int i = 0; i < 4; ++i) { g0[i] = sigmoidf_(v0[i] + b0[i]); g0[4 + i] = sigmoidf_(v0[4 + i] + b1[i]); g1[i] = sigmoidf_(v1[i] + b2[i]); g1[4 + i] = sigmoidf_(v1[4 + i] + b3[i]); }
                bf16_t* p = g + (size_t)row * 2048 + c;
                *(u32x4*)p = pack8(g0); *(u32x4*)(p + 128) = pack8(g1);
            PROJ_ROWS_END
        }
#undef PROJ_ROWS_BEGIN
#undef PROJ_ROWS_END
    }
};

struct EpiQ {
    static constexpr bool PERM = true, AFTER_DRAIN = false;
    unsigned char* ws;
    __device__ __forceinline__ void operator()(const Acc& acc, const Unit& u, int wr, int wc, int fr, int fq) const {
        const float* ssqq = (const float*)(ws + WS_SSQQ); const float* cs = (const float*)(ws + WS_COS); const float* sn = (const float*)(ws + WS_SIN); bf16_t* q = (bf16_t*)(ws + WS_Q);
#pragma unroll
        for (int ai = 0; ai < 2; ++ai)
#pragma unroll
            for (int m = 0; m < 4; ++m) {
                const int row = EPI_ROW(ai, m);
                const float inv = rsqrtf(sum4(ssqq + (size_t)row * 4) * (1.0f / QL) + EPS) * C2;
#pragma unroll
                for (int bj = 0; bj < 2; ++bj) {
                    float v[8]; EPI_GET8(v, ai, bj, m, inv);
                    const int c = u.pn * 256 + bj * 128 + wc * 32 + 8 * fq, d = c % 96;
                    if (d >= 64) { const int p0 = (d - 64) >> 1;
                        const f32x4 c4 = *(const f32x4*)(cs + (size_t)row * 16 + p0), s4 = *(const f32x4*)(sn + (size_t)row * 16 + p0);
#pragma unroll
                        for (int j = 0; j < 4; ++j) { const float t1 = v[2 * j], t2 = v[2 * j + 1]; v[2 * j] = t1 * c4[j] - t2 * s4[j]; v[2 * j + 1] = t1 * s4[j] + t2 * c4[j]; } }
                    *(u32x4*)(q + (size_t)row * 1536 + c) = pack8(v);
                }
            }
    }
};
struct EpiKV {
    static constexpr bool PERM = true, AFTER_DRAIN = false;
    unsigned char* ws;
    __device__ __forceinline__ void operator()(const Acc& acc, const Unit& u, int wr, int wc, int fr, int fq) const {
        const float* ssqkv = (const float*)(ws + WS_SSQKV); bf16_t* kk = (bf16_t*)(ws + WS_K); bf16_t* vv = (bf16_t*)(ws + WS_V);
#pragma unroll
        for (int ai = 0; ai < 2; ++ai)
#pragma unroll
            for (int m = 0; m < 4; ++m) {
                const int row = EPI_ROW(ai, m);
                const float inv = rsqrtf(sum4(ssqkv + (size_t)row * 4) * (1.0f / KVL) + EPS);
#pragma unroll
                for (int bj = 0; bj < 2; ++bj) {
                    float v[8]; EPI_GET8(v, ai, bj, m, inv);
                    const int c = u.pn * 256 + bj * 128 + wc * 32 + 8 * fq, h = c >> 7, j = c & 127;
                    if (j < 64) *(u32x4*)(kk + (size_t)row * 1536 + 96 * h + j) = pack8(v);
                    else *(u32x4*)(vv + (size_t)row * 1024 + 64 * h + (j - 64)) = pack8(v);
                }
            }
    }
};
template <int MODE> struct EpiGate {
    static constexpr bool PERM = true, AFTER_DRAIN = false;
    unsigned char* ws;
    __device__ __forceinline__ void operator()(const Acc& acc, const Unit& u, int wr, int wc, int fr, int fq) const {
        const bf16_t* g = (const bf16_t*)(ws + WS_G); bf16_t* mx = (bf16_t*)(ws + WS_MX);
#pragma unroll
        for (int ai = 0; ai < 2; ++ai)
#pragma unroll
            for (int m = 0; m < 4; ++m) {
                const int row = EPI_ROW(ai, m);
#pragma unroll
                for (int bj = 0; bj < 2; ++bj) {
                    float v[8]; EPI_GET8(v, ai, bj, m, 1.0f);
                    const int c = u.pn * 256 + bj * 128 + wc * 32 + 8 * fq;
                    float gg[8]; unpack8(*(const u32x4*)(g + (size_t)row * 2048 + MODE * 1024 + c), gg);
                    bf16_t* p = mx + (size_t)row * 1024 + c;
                    if (MODE == 1) { float o[8]; unpack8(*(const u32x4*)p, o);
#pragma unroll
                        for (int i = 0; i < 8; ++i) v[i] = o[i] + gg[i] * v[i]; }
                    else {
#pragma unroll
                        for (int i = 0; i < 8; ++i) v[i] = gg[i] * v[i]; }
                    *(u32x4*)p = pack8(v);
                }
            }
    }
};
struct EpiResid {
    static constexpr bool PERM = true, AFTER_DRAIN = false;
    const float* hin; float* h; unsigned char* ws;
    __device__ __forceinline__ void operator()(const Acc& acc, const Unit& u, int wr, int wc, int fr, int fq) const {
        bf16_t* hb = (bf16_t*)(ws + WS_HB); float* ssqh = (float*)(ws + WS_SSQH);
#pragma unroll
        for (int ai = 0; ai < 2; ++ai)
#pragma unroll
            for (int m = 0; m < 4; ++m) {
                const int row = EPI_ROW(ai, m); float s = 0.f;
#pragma unroll
                for (int bj = 0; bj < 2; ++bj) {
                    float v[8]; EPI_GET8(v, ai, bj, m, 1.0f);
                    const size_t o = (size_t)row * 1024 + u.pn * 256 + bj * 128 + wc * 32 + 8 * fq;
                    const f32x4 r0 = *(const f32x4*)(hin + o), r1 = *(const f32x4*)(hin + o + 4);
#pragma unroll
                    for (int i = 0; i < 4; ++i) { v[i] += r0[i]; v[4 + i] += r1[i]; }
                    *(f32x4*)(h + o) = (f32x4){v[0], v[1], v[2], v[3]}; *(f32x4*)(h + o + 4) = (f32x4){v[4], v[5], v[6], v[7]};
                    *(u32x4*)(hb + o) = pack8(v);
                    s += sumsq8(v);
                }
                s += __shfl_xor(s, 16); s += __shfl_xor(s, 32);
                if (fq == 0) ssqh[(size_t)row * 16 + 4 * u.pn + wc] = s;
            }
    }
};
struct EpiSwiglu {
    static constexpr bool PERM = true, AFTER_DRAIN = false;
    const float* ssqh; bf16_t* act; int ldc;
    __device__ __forceinline__ void operator()(const Acc& acc, const Unit& u, int wr, int wc, int fr, int fq) const {
#pragma unroll
        for (int ai = 0; ai < 2; ++ai)
#pragma unroll
            for (int m = 0; m < 4; ++m) {
                const int row = EPI_ROW(ai, m);
                const float inv = ssqh ? rsqrtf(sum16(ssqh + (size_t)row * 16) * (1.0f / D) + EPS) : 1.0f;
                float v0[8], v1[8]; EPI_GET8(v0, ai, 0, m, inv); EPI_GET8(v1, ai, 1, m, inv);
#pragma unroll
                for (int i = 0; i < 8; ++i) v0[i] = v0[i] * sigmoidf_(v0[i]) * v1[i];
                *(u32x4*)(act + (size_t)row * ldc + 128 * u.pn + wc * 32 + 8 * fq) = pack8(v0);
            }
    }
};
struct EpiStore {
    static constexpr bool PERM = true, AFTER_DRAIN = false;
    bf16_t* o; int ldc;
    __device__ __forceinline__ void operator()(const Acc& acc, const Unit& u, int wr, int wc, int fr, int fq) const {
#pragma unroll
        for (int ai = 0; ai < 2; ++ai)
#pragma unroll
            for (int m = 0; m < 4; ++m) {
                const int row = EPI_ROW(ai, m);
#pragma unroll
                for (int bj = 0; bj < 2; ++bj) { float v[8]; EPI_GET8(v, ai, bj, m, 1.0f);
                    *(u32x4*)(o + (size_t)row * ldc + u.pn * 256 + bj * 128 + wc * 32 + 8 * fq) = pack8(v); }
            }
    }
};

template <class Epi, class WF>
__device__ __forceinline__ void naive_gemm_phase(LAS unsigned char* lds, const bf16_t* A, int K, const pg8::StaticOrder& S, const Epi& E, const WF& wf, int wave_) {
    const int lane = lane_id_opaque(), wid = wave_, tid = wid * 64 + lane, wr = wid >> 2, wc = wid & 3, fr = lane & 15, fq = lane >> 4;
    LAS float* As = (LAS float*)lds;
    LAS float* Ws = As + 16 * 256;
    const int ar = tid >> 1, ak = (tid & 1) * 8, wk = tid >> 5, wcg = (tid & 31) * 8;
    Unit u;
    for (int ui = 0; S.next(ui, u); ++ui) {
        Acc acc;
#pragma unroll
        for (int a = 0; a < 2; ++a)
#pragma unroll
            for (int b = 0; b < 2; ++b)
#pragma unroll
                for (int m = 0; m < 4; ++m)
#pragma unroll
                    for (int n = 0; n < 2; ++n) acc[a][b][m][n] = (f32x4){0.f, 0.f, 0.f, 0.f};
        const bf16_t* arow = A + (size_t)(u.pm * 256 + ar) * K + ak;
#pragma unroll 1
        for (int k0 = 0; k0 < K; k0 += 16) {
            { float af[8]; unpack8(*(const u32x4*)(arow + k0), af);
#pragma unroll
              for (int i = 0; i < 8; ++i) As[(ak + i) * 256 + ar] = af[i];
#pragma unroll
              for (int i = 0; i < 8; ++i) Ws[wk * 256 + wcg + i] = wf(k0 + wk, u.pn * 256 + wcg + i, u.e); }
            LDS_WAIT(); __syncthreads();
#pragma unroll 2
            for (int kk = 0; kk < 16; ++kk) {
                float a[2][4], w[2][8];
#pragma unroll
                for (int ai = 0; ai < 2; ++ai)
#pragma unroll
                    for (int m = 0; m < 4; ++m) a[ai][m] = As[kk * 256 + ai * 128 + wr * 64 + m * 16 + fr];
#pragma unroll
                for (int bj = 0; bj < 2; ++bj)
#pragma unroll
                    for (int i = 0; i < 8; ++i) w[bj][i] = Ws[kk * 256 + bj * 128 + wc * 32 + 8 * fq + i];
#pragma unroll
                for (int ai = 0; ai < 2; ++ai)
#pragma unroll
                    for (int bj = 0; bj < 2; ++bj)
#pragma unroll
                        for (int m = 0; m < 4; ++m)
#pragma unroll
                            for (int n = 0; n < 2; ++n)
#pragma unroll
                                for (int j = 0; j < 4; ++j) acc[ai][bj][m][n][j] += a[ai][m] * w[bj][4 * n + j];
            }
            LDS_WAIT(); __syncthreads();
        }
        E(acc, u, wr, wc, fr, fq);
    }
}


template <bool FAST, bool ALIGN, class Epi, class WF>
__device__ __forceinline__ void run_gemm(LAS unsigned char* lds, const bf16_t* A, const bf16_t* Bt, size_t estride_bt, int K, const pg8::StaticOrder& S, const Epi& E, const WF& wf, int wave_) {
    if constexpr (FAST) { pg8::Gemm g{A, Bt, K, estride_bt}; pg8::gemm_phase<Epi, pg8::StaticOrder, ALIGN, true>(lds, g, S, E, wave_); }
    else naive_gemm_phase(lds, A, K, S, E, wf, wave_);
}

#define XB_TMO      128
#define XB_XCNT(j)  (256  + 64 * (j))
#define XB_XSUB(j)  (1280 + 64 * (j))
#define XB_XGEN(j)  (2304 + 64 * (j))
#define XB_TOP      3328
#define XB_TOPGEN   3392
#define XCD_BAR_WORDS 3456
#define XB_SPIN_CAP (1u << 22)
__device__ __forceinline__ unsigned xb_ld(unsigned* p)              { return __hip_atomic_load(p, __ATOMIC_RELAXED, __HIP_MEMORY_SCOPE_AGENT); }
__device__ __forceinline__ unsigned xb_add(unsigned* p, unsigned v) { return __hip_atomic_fetch_add(p, v, __ATOMIC_RELAXED, __HIP_MEMORY_SCOPE_AGENT); }
__device__ __forceinline__ unsigned xb_xcc_id() { return (unsigned)__builtin_amdgcn_s_getreg((3 << 11) | 20) & 0xFu; }
#define XB_SPIN(cond, bar) do { unsigned _sp = 0; while (cond) { __builtin_amdgcn_s_sleep(1); \
    if ((++_sp & 255u) == 0u) { if (xb_ld(&(bar)[XB_TMO])) break; if (_sp > XB_SPIN_CAP) { atomicAdd(&(bar)[XB_TMO], 1u); break; } } } } while (0)
struct XcdBarrier { unsigned* bar; unsigned x; volatile LAS unsigned* st; };
__device__ __forceinline__ XcdBarrier xcd_barrier_post(unsigned* bar, volatile LAS unsigned* st) {
    XcdBarrier b; b.bar = bar; b.x = xb_xcc_id(); b.st = st;
    if (threadIdx.x == 0) (void)xb_add(&bar[XB_XCNT(b.x)], 1u);
    return b;
}
__device__ __forceinline__ void xcd_barrier_complete(unsigned* bar, unsigned x, unsigned& nloc, unsigned& nx) {
    const unsigned G = gridDim.x * gridDim.y * gridDim.z;
    unsigned sum, cnt, mine, sp = 0u;
    for (;;) {
        sum = 0u; cnt = 0u; mine = 0u;
#pragma unroll
        for (unsigned j = 0; j < 16; ++j) { const unsigned c = xb_ld(&bar[XB_XCNT(j)]); sum += c; cnt += (c > 0u) ? 1u : 0u; mine = (j == x) ? c : mine; }
        if (sum == G) break;
        __builtin_amdgcn_s_sleep(1);
        if ((++sp & 255u) == 0u) { if (xb_ld(&bar[XB_TMO])) break; if (sp > XB_SPIN_CAP) { atomicAdd(&bar[XB_TMO], 1u); break; } }
    }
    nloc = mine > 0u ? mine : 1u; nx = cnt > 0u ? cnt : 1u;
}
__device__ __forceinline__ void xcd_barrier(const XcdBarrier& b, int wave_) {
    asm volatile("s_waitcnt vmcnt(0)" ::: "memory");
    __syncthreads();
    if (wave_ == 0 && lane_id_opaque() == 0) {
        unsigned* bar = b.bar; unsigned bx_ = b.x; asm volatile("" : "+s"(bar), "+s"(bx_));
        __builtin_amdgcn_s_waitcnt(0);
        unsigned nloc = b.st[0], nx = b.st[1];
        if (nloc == 0u) { xcd_barrier_complete(bar, bx_, nloc, nx); b.st[0] = nloc; b.st[1] = nx; }
        const unsigned old = xb_add(&bar[XB_XSUB(bx_)], 1u);
        const unsigned gen = old / nloc;
        if (old + 1u == (gen + 1u) * nloc) {
            __builtin_amdgcn_fence(__ATOMIC_RELEASE, "agent");
            asm volatile("s_waitcnt vmcnt(0)" ::: "memory");
            const unsigned og = xb_add(&bar[XB_TOP], 1u);
            const unsigned tg = og / nx;
            if (og + 1u == (tg + 1u) * nx) xb_add(&bar[XB_TOPGEN], 1u);
            else XB_SPIN(xb_ld(&bar[XB_TOPGEN]) == tg, bar);
            __builtin_amdgcn_fence(__ATOMIC_ACQUIRE, "agent");
            xb_add(&bar[XB_XGEN(bx_)], 1u);
            asm volatile("s_waitcnt vmcnt(0)" ::: "memory");
        } else {
            XB_SPIN(xb_ld(&bar[XB_XGEN(bx_)]) == gen, bar);
            __builtin_amdgcn_fence(__ATOMIC_ACQUIRE, "agent");
            asm volatile("s_waitcnt vmcnt(0)" ::: "memory");
        }
    }
    __syncthreads();
}

struct Args { const float* in[22]; float* out; unsigned char* ws; };
struct Frame {
    LAS unsigned char* lds; volatile LAS unsigned* MISC;
    int tid, lane;
    int wave, vcu, G;
};

__device__ __forceinline__ void p0_rows(Frame& F_, unsigned char* ws, const float* x, const int* pos) {
    Frame F = F_; F.lane = lane_id_opaque(); F.tid = F.wave * 64 + F.lane;
    const int gw = F.vcu * NWAVES + F.wave, NGW = F.G * NWAVES;
    bf16_t* hb = (bf16_t*)(ws + WS_HB); float* ssqh = (float*)(ws + WS_SSQH);
    for (int r = gw; r < M; r += NGW) {
        const f32x4* xr = (const f32x4*)(x + (size_t)r * D) + F.lane; f32x4 v[4]; float s = 0.f;
#pragma unroll
        for (int j = 0; j < 4; ++j) { v[j] = xr[64 * j]; s += (v[j][0] * v[j][0] + v[j][1] * v[j][1]) + (v[j][2] * v[j][2] + v[j][3] * v[j][3]); }
        s = wave_sum(s);
        u32x2* o = (u32x2*)(hb + (size_t)r * D) + F.lane;
#pragma unroll
        for (int j = 0; j < 4; ++j) { u32x2 w; w.x = pk2(v[j][0], v[j][1]); w.y = pk2(v[j][2], v[j][3]); o[64 * j] = w; }
        if (F.lane < 16) ssqh[(size_t)r * 16 + F.lane] = (F.lane == 0) ? s : 0.f;
    }
    float* cs = (float*)(ws + WS_COS); float* sn = (float*)(ws + WS_SIN);
    const double invf[16] = {1.0, 0.5623413251903491, 0.31622776601683794, 0.1778279410038923, 0.1, 0.05623413251903491, 0.03162277660168379, 0.01778279410038923,
                             0.01, 0.005623413251903491, 0.0031622776601683794, 0.0017782794100389228, 0.001, 0.0005623413251903491, 0.00031622776601683794, 0.00017782794100389227};
    for (int idx = (F.vcu * NWAVES + F.wave) * 64 + F.lane; idx < M * 16; idx += NGW * 64) {
        const int r = idx >> 4, i = idx & 15;
        double f = invf[0];
#pragma unroll
        for (int j = 1; j < 16; ++j) f = (i == j) ? invf[j] : f;
        const float angf = (float)pos[r] * (float)f;
        const double a = (double)angf;
        const double n = __builtin_rint(a * 0.6366197723675814);
        const double rr = (a - n * 1.5707963267948966) - n * 6.123233995736766e-17;
        const double r2 = rr * rr;
        const double sp = rr * (1.0 + r2 * (-1.0 / 6 + r2 * (1.0 / 120 + r2 * (-1.0 / 5040 + r2 * (1.0 / 362880 + r2 * (-1.0 / 39916800 + r2 * (1.0 / 6227020800.0)))))));
        const double cp = 1.0 + r2 * (-0.5 + r2 * (1.0 / 24 + r2 * (-1.0 / 720 + r2 * (1.0 / 40320 + r2 * (-1.0 / 3628800 + r2 * (1.0 / 479001600.0))))));
        const int q = ((int)n) & 3;
        const double sv = (q == 0) ? sp : (q == 1) ? cp : (q == 2) ? -sp : -cp;
        const double cv = (q == 0) ? cp : (q == 1) ? -sp : (q == 2) ? -cp : sp;
        cs[idx] = (float)cv; sn[idx] = (float)sv;
    }
}

template <class WF>
__device__ __forceinline__ void prep_item(const WF& wf, int K, int N, int e, bf16_t* Bt, LAS float* scr, int item, int lane) {
    const int nblk = N / 32, kb = item / nblk, nb = item % nblk, k0 = 64 * kb, n0 = 32 * nb;
#pragma unroll 8
    for (int i = 0; i < 32; ++i) { const int kk = 2 * i + (lane >> 5); scr[kk * 33 + (lane & 31)] = wf(k0 + kk, n0 + (lane & 31), e); }
    LDS_WAIT(); asm volatile("" ::: "memory");
    const int c = lane & 7;
#pragma unroll
    for (int j = 0; j < 4; ++j) { const int n = (lane >> 3) + 8 * j; const LAS float* s = scr + (8 * c) * 33 + n;
        u32x4 o; o.x = pk2(s[0 * 33], s[1 * 33]); o.y = pk2(s[2 * 33], s[3 * 33]); o.z = pk2(s[4 * 33], s[5 * 33]); o.w = pk2(s[6 * 33], s[7 * 33]);
        *(u32x4*)(Bt + (size_t)(n0 + n) * K + k0 + 8 * c) = o; }
    LDS_WAIT(); asm volatile("" ::: "memory");
}
template <class WF>
__device__ __forceinline__ void prep_weight(Frame& F_, const WF& wf, int K, int N, int ne, bf16_t* Bt, size_t estride, int& itbase) {
    Frame F = F_; F.lane = lane_id_opaque(); F.tid = F.wave * 64 + F.lane;
    LAS float* scr = (LAS float*)(F.lds + RING_OFF + F.wave * 16384);
    const int gw = F.vcu * NWAVES + F.wave, NGW = F.G * NWAVES;
    const int per = (K / 64) * (N / 32), n = per * ne;
    int first = (gw - (itbase % NGW) + NGW) % NGW;
    for (int it = first; it < n; it += NGW) { const int e = it / per; prep_item(wf, K, N, e, Bt + (size_t)e * estride, scr, it % per, F.lane); }
    itbase += n;
}

__device__ __forceinline__ void conv_pass(Frame& F_, unsigned char* ws, const float* cw) {
    Frame F = F_; F.lane = lane_id_opaque(); F.tid = F.wave * 64 + F.lane;
    const int gw = F.vcu * NWAVES + F.wave, NGW = F.G * NWAVES;
    const bf16_t* z0 = (const bf16_t*)(ws + WS_Z0); bf16_t* gb = (bf16_t*)(ws + WS_GB);
    for (int it = gw; it < (M / 8) * 2; it += NGW) {
        const int t0 = (it >> 1) * 8, c0 = (it & 1) * 512 + F.lane * 8;
        float w0[8], w1[8], w2[8];
#pragma unroll
        for (int i = 0; i < 8; ++i) { w0[i] = cw[c0 + i]; w1[i] = cw[1024 + c0 + i]; w2[i] = cw[2048 + c0 + i]; }
        float zm2[8], zm1[8];
        if ((t0 % SEQ) != 0) { unpack8(*(const u32x4*)(z0 + (size_t)(t0 - 2) * 1024 + c0), zm2); unpack8(*(const u32x4*)(z0 + (size_t)(t0 - 1) * 1024 + c0), zm1); }
        else {
#pragma unroll
            for (int i = 0; i < 8; ++i) { zm2[i] = 0.f; zm1[i] = 0.f; } }
#pragma unroll
        for (int r = 0; r < 8; ++r) {
            float z[8], g[8], o[8]; unpack8(*(const u32x4*)(z0 + (size_t)(t0 + r) * 1024 + c0), z); unpack8(*(const u32x4*)(gb + (size_t)(t0 + r) * 1024 + c0), g);
#pragma unroll
            for (int i = 0; i < 8; ++i) { o[i] = g[i] * (w0[i] * zm2[i] + w1[i] * zm1[i] + w2[i] * z[i]); zm2[i] = zm1[i]; zm1[i] = z[i]; }
            *(u32x4*)(gb + (size_t)(t0 + r) * 1024 + c0) = pack8(o);
        }
    }
}

__device__ __forceinline__ void naive_attention(Frame& F_, unsigned char* ws) {
    Frame F = F_; F.lane = lane_id_opaque(); F.tid = F.wave * 64 + F.lane;
    const int gw = F.vcu * NWAVES + F.wave, NGW = F.G * NWAVES;
    const bf16_t* Q = (const bf16_t*)(ws + WS_Q); const bf16_t* K = (const bf16_t*)(ws + WS_K); const bf16_t* V = (const bf16_t*)(ws + WS_V); bf16_t* O = (bf16_t*)(ws + WS_O);
    for (int it = gw; it < NB * NH * 32; it += NGW) {
        const int ck = 31 - (it / (NB * NH)), bh = it % (NB * NH), b = bh / NH, h = bh % NH;
        const size_t row = (size_t)b * SEQ + ck * 64 + F.lane;
        float q[96];
#pragma unroll
        for (int j = 0; j < 12; ++j) unpack8(*(const u32x4*)(Q + row * 1536 + 96 * h + 8 * j), q + 8 * j);
        float o[64];
#pragma unroll
        for (int i = 0; i < 64; ++i) o[i] = 0.f;
        float mx = -INFINITY, l = 0.f;
        const int nk = (ck + 1) * 64;
        for (int j = 0; j < nk; ++j) {
            const size_t kr = (size_t)b * SEQ + j;
            float s = 0.f;
#pragma unroll
            for (int c = 0; c < 12; ++c) { float kf[8]; unpack8(*(const u32x4*)(K + kr * 1536 + 96 * h + 8 * c), kf);
#pragma unroll
                for (int i = 0; i < 8; ++i) s += q[8 * c + i] * kf[i]; }
            const float mn = fmaxf(mx, s), corr = exp2f(mx - mn), p = exp2f(s - mn);
            l = l * corr + p; mx = mn;
#pragma unroll
            for (int c = 0; c < 8; ++c) { float vf[8]; unpack8(*(const u32x4*)(V + kr * 1024 + 64 * h + 8 * c), vf);
#pragma unroll
                for (int i = 0; i < 8; ++i) o[8 * c + i] = o[8 * c + i] * corr + p * vf[i]; }
        }
        const float rl = 1.0f / l;
#pragma unroll
        for (int c = 0; c < 8; ++c) { float t[8];
#pragma unroll
            for (int i = 0; i < 8; ++i) t[i] = o[8 * c + i] * rl;
            *(u32x4*)(O + row * 1024 + 64 * h + 8 * c) = pack8(t); }
    }
}


namespace attn {
typedef float f32x16 __attribute__((ext_vector_type(16)));
typedef short s16x4 __attribute__((ext_vector_type(4)));
constexpr int KSLOT = 12288, VSLOT = 8192, NSLOT = 3;
constexpr int LDS_K = 0, LDS_V = NSLOT * KSLOT, LDS_WS = LDS_V + NSLOT * VSLOT, LDS_OST = LDS_WS + NWAVES * 256, LDS_TOTAL = LDS_OST + NWAVES * 4096;
static_assert(LDS_TOTAL <= RING_BYTES, "attention LDS");
constexpr float THR = 8.0f;
__device__ __forceinline__ int crow(int r, int hi) { return (r & 3) + 8 * (r >> 2) + 4 * hi; }
#define ATT_SBAR() __builtin_amdgcn_sched_barrier(0)
#define ATT_WAIT_BAR(N) asm volatile("s_waitcnt vmcnt(" #N ") lgkmcnt(0)\n\ts_barrier" ::: "memory")
__device__ __forceinline__ void glds16(const void* gsrc, unsigned lds_dst) { unsigned keep;
    asm volatile("s_mov_b32 %0, m0\n\ts_mov_b32 m0, %2\n\ts_nop 0\n\tglobal_load_lds_dwordx4 %1, off\n\ts_mov_b32 m0, %0" : "=&s"(keep) : "v"(gsrc), "s"(lds_dst) : "memory"); }
__device__ __forceinline__ void pv(f32x16* o, unsigned vb, bf16x8 pa0, bf16x8 pa1, bf16x8 pa2, bf16x8 pa3) {
#pragma unroll
    for (int d0 = 0; d0 < 2; ++d0) { s16x4 lo[4], hi[4];
#pragma unroll
        for (int ks = 0; ks < 4; ++ks) {
            asm volatile("ds_read_b64_tr_b16 %0,%1 offset:%c2" : "=&v"(lo[ks]) : "v"(vb), "i"(d0 * 4096 + ks * 1024) : "memory");
            asm volatile("ds_read_b64_tr_b16 %0,%1 offset:%c2" : "=&v"(hi[ks]) : "v"(vb), "i"(d0 * 4096 + ks * 1024 + 512) : "memory"); }
        asm volatile("s_waitcnt lgkmcnt(0)" ::: "memory"); ATT_SBAR();
#define ATT_PK(k) (bf16x8){lo[k][0], lo[k][1], lo[k][2], lo[k][3], hi[k][0], hi[k][1], hi[k][2], hi[k][3]}
        o[d0] = __builtin_amdgcn_mfma_f32_32x32x16_bf16(pa0, ATT_PK(0), o[d0], 0, 0, 0);
        o[d0] = __builtin_amdgcn_mfma_f32_32x32x16_bf16(pa1, ATT_PK(1), o[d0], 0, 0, 0);
        o[d0] = __builtin_amdgcn_mfma_f32_32x32x16_bf16(pa2, ATT_PK(2), o[d0], 0, 0, 0);
        o[d0] = __builtin_amdgcn_mfma_f32_32x32x16_bf16(pa3, ATT_PK(3), o[d0], 0, 0, 0);
#undef ATT_PK
    }
}
__device__ __forceinline__ void attn_unit(int b, int h, int qb, const bf16_t* Q, const bf16_t* K, const bf16_t* V, bf16_t* O, LAS unsigned char* shm, int wid, int lane) {
    const int r32 = lane & 31, hi = lane >> 5;
    const long rowbase = (long)b * SEQ; const int q0 = qb * 256;
    const bf16_t* Qw = Q + (rowbase + q0 + wid * 32) * 1536 + h * 96;
    const bf16_t* Kh = K + rowbase * 1536 + h * 96; const bf16_t* Vh = V + rowbase * 1024 + h * 64;
    const unsigned lds0 = (unsigned)(size_t)shm;
    LAS float* wsf = (LAS float*)(shm + LDS_WS) + wid * 64;
    const bf16_t* ksrc = Kh + (long)lane * 1536 + wid * 8;
    const bf16_t* vsrc = Vh + (long)(16 * (wid & 3) + (lane >> 2)) * 1024 + (wid >> 2) * 32 + (lane & 3) * 8;
    const unsigned kdst = lds0 + LDS_K + wid * 1024, vdst = lds0 + LDS_V + wid * 1024;
#define ATT_DMA(t, sl) do { glds16(ksrc + (long)(t) * 64 * 1536, (unsigned)__builtin_amdgcn_readfirstlane(kdst + (sl) * KSLOT)); \
        if (wid < 4) glds16(ksrc + (long)(t) * 64 * 1536 + 64, (unsigned)__builtin_amdgcn_readfirstlane(kdst + (sl) * KSLOT + 8192)); \
        glds16(vsrc + (long)(t) * 64 * 1024, (unsigned)__builtin_amdgcn_readfirstlane(vdst + (sl) * VSLOT)); } while (0)
    const unsigned vb0 = lds0 + LDS_V + ((lane >> 4) & 1) * 32 + (lane & 3) * 8 + (4 * hi + ((lane & 15) >> 2)) * 64;
    const int NT = 4 * qb + 4, tmax = 4 * qb + (wid >> 1);
    bf16x8 qr[6];
#pragma unroll
    for (int d0 = 0; d0 < 6; ++d0) qr[d0] = *(const bf16x8*)(Qw + (long)r32 * 1536 + d0 * 16 + hi * 8);
    ATT_DMA(0, 0); ATT_DMA(1, 1);
    float mhat = 0.f, l_reg = 0.f; f32x16 o[2]; o[0] = f32x16{}; o[1] = f32x16{};
    int slot = 0, slot2 = 2;
    for (int t = 0; t < NT; ++t) {
        if (t + 1 < NT) { if (wid < 4) ATT_WAIT_BAR(3); else ATT_WAIT_BAR(2); } else ATT_WAIT_BAR(0);
        if (t + 2 < NT) ATT_DMA(t + 2, slot2);
        if (t <= tmax) {
            const LAS unsigned char* kb = shm + LDS_K + slot * KSLOT + hi * 1024 + r32 * 16;
            f32x16 p0 = f32x16{}, p1 = f32x16{};
#pragma unroll
            for (int d0 = 0; d0 < 6; ++d0) {
                const bf16x8 b0 = *(const LAS bf16x8*)(kb + d0 * 2048), b1 = *(const LAS bf16x8*)(kb + d0 * 2048 + 512);
                p0 = __builtin_amdgcn_mfma_f32_32x32x16_bf16(b0, qr[d0], p0, 0, 0, 0);
                p1 = __builtin_amdgcn_mfma_f32_32x32x16_bf16(b1, qr[d0], p1, 0, 0, 0);
            }
            float rm = fmaxf(p0[0], p1[0]);
#pragma unroll
            for (int r = 1; r < 16; ++r) rm = fmaxf(rm, fmaxf(p0[r], p1[r]));
            { auto rr = __builtin_amdgcn_permlane32_swap(__float_as_uint(rm), __float_as_uint(rm), false, false); rm = fmaxf(__uint_as_float(rr[0]), __uint_as_float(rr[1])); }
            if (t == 0) mhat = rm;
            else if (__any(rm > mhat + THR)) {
                const float mn = fmaxf(mhat, rm), f = __builtin_amdgcn_exp2f(mhat - mn); mhat = mn; l_reg *= f;
                if (hi == 0) wsf[r32] = f;
                asm volatile("s_waitcnt lgkmcnt(0)" ::: "memory");
#pragma unroll
                for (int r = 0; r < 16; ++r) { const float fr_ = wsf[crow(r, hi)]; o[0][r] *= fr_; o[1][r] *= fr_; }
                asm volatile("s_waitcnt lgkmcnt(0)" ::: "memory");
            }
            float sacc = 0.f;
#pragma unroll
            for (int r = 0; r < 16; ++r) { p0[r] = __builtin_amdgcn_exp2f(p0[r] - mhat); p1[r] = __builtin_amdgcn_exp2f(p1[r] - mhat); sacc += p0[r] + p1[r]; }
            l_reg += sacc;
            u32x4 pw0, pw1, pw2, pw3;
            pw0 = (u32x4){pk2(p0[0], p0[1]), pk2(p0[2], p0[3]), pk2(p0[4], p0[5]), pk2(p0[6], p0[7])};
            pw1 = (u32x4){pk2(p0[8], p0[9]), pk2(p0[10], p0[11]), pk2(p0[12], p0[13]), pk2(p0[14], p0[15])};
            pw2 = (u32x4){pk2(p1[0], p1[1]), pk2(p1[2], p1[3]), pk2(p1[4], p1[5]), pk2(p1[6], p1[7])};
            pw3 = (u32x4){pk2(p1[8], p1[9]), pk2(p1[10], p1[11]), pk2(p1[12], p1[13]), pk2(p1[14], p1[15])};
            ATT_SBAR();
            pv(o, vb0 + slot * VSLOT, __builtin_bit_cast(bf16x8, pw0), __builtin_bit_cast(bf16x8, pw1), __builtin_bit_cast(bf16x8, pw2), __builtin_bit_cast(bf16x8, pw3));
        }
        slot = (slot == NSLOT - 1) ? 0 : slot + 1; slot2 = (slot2 == NSLOT - 1) ? 0 : slot2 + 1;
    }
    { auto rr = __builtin_amdgcn_permlane32_swap(__float_as_uint(l_reg), __float_as_uint(l_reg), false, false); l_reg = __uint_as_float(rr[0]) + __uint_as_float(rr[1]); }
    if (hi == 0) wsf[32 + r32] = l_reg;
    asm volatile("s_waitcnt lgkmcnt(0)" ::: "memory");
    float rli[16];
#pragma unroll
    for (int r = 0; r < 16; ++r) rli[r] = __builtin_amdgcn_rcpf(wsf[32 + crow(r, hi)]);
    bf16_t* Ow = O + (rowbase + q0 + wid * 32) * 1024 + h * 64;
    { LAS bf16_t* stg = (LAS bf16_t*)(shm + LDS_OST) + wid * 2048;
#pragma unroll
      for (int r = 0; r < 16; ++r) { const int orow = crow(r, hi);
#pragma unroll
          for (int d0 = 0; d0 < 2; ++d0) stg[orow * 64 + d0 * 32 + r32] = (bf16_t)(pk2(o[d0][r] * rli[r], 0.f) & 0xffffu); }
      asm volatile("s_waitcnt lgkmcnt(0)" ::: "memory");
#pragma unroll
      for (int i = 0; i < 4; ++i) { const int row = i * 8 + (lane >> 3), ch = lane & 7; const u32x4 v = *(const LAS u32x4*)(stg + row * 64 + ch * 8); *(u32x4*)(Ow + (long)row * 1024 + ch * 8) = v; } }
    asm volatile("s_waitcnt lgkmcnt(0)\n\ts_barrier" ::: "memory");
#undef ATT_DMA
}
__device__ __forceinline__ void attn_phase(LAS unsigned char* lds, unsigned char* ws, int vcu, int wave_) {
    const int lane = lane_id_opaque();
    const int bh = vcu >> 1, par = vcu & 1;
#pragma unroll 1
    for (int i = 0; i < 4; ++i) {
        const int qb = par ? ((i == 0) ? 6 : (i == 1) ? 1 : (i == 2) ? 5 : 2) : ((i == 0) ? 7 : (i == 1) ? 0 : (i == 2) ? 4 : 3);
        attn_unit(bh / NH, bh % NH, qb, (const bf16_t*)(ws + WS_Q), (const bf16_t*)(ws + WS_K), (const bf16_t*)(ws + WS_V), (bf16_t*)(ws + WS_O), lds, wave_, lane);
    }
}
#undef ATT_SBAR
#undef ATT_WAIT_BAR
}

__device__ __forceinline__ void route_pass1(Frame& F_, unsigned char* ws, const float* H, const float* gain, const float* rw) {
    Frame F = F_; F.lane = lane_id_opaque(); F.tid = F.wave * 64 + F.lane;
    const int wg = blockIdx.x, t0 = wg * 64;
    LAS int* se = (LAS int*)(F.lds + RING_OFF);
    LAS int* rk = se + 128;
    float* invf = (float*)(ws + WS_INVF); float* topw = (float*)(ws + WS_TOPW);
    for (int i = 0; i < 8; ++i) {
        const int tl = F.wave * 8 + i, t = t0 + tl;
        const f32x4* hr = (const f32x4*)(H + (size_t)t * D) + F.lane; f32x4 v[4]; float s = 0.f;
#pragma unroll
        for (int j = 0; j < 4; ++j) { v[j] = hr[64 * j]; s += (v[j][0] * v[j][0] + v[j][1] * v[j][1]) + (v[j][2] * v[j][2] + v[j][3] * v[j][3]); }
        s = wave_sum(s);
        const float inv = rsqrtf(s * (1.0f / D) + EPS);
        float lg[8];
#pragma unroll
        for (int e = 0; e < 8; ++e) lg[e] = 0.f;
#pragma unroll
        for (int j = 0; j < 4; ++j) {
            const int k = 4 * (F.lane + 64 * j);
            const f32x4 g4 = *(const f32x4*)(gain + k);
#pragma unroll
            for (int c = 0; c < 4; ++c) { const float xn = (v[j][c] * inv) * g4[c];
                const f32x4 r0 = *(const f32x4*)(rw + (size_t)(k + c) * 8), r1 = *(const f32x4*)(rw + (size_t)(k + c) * 8 + 4);
                lg[0] += xn * r0[0]; lg[1] += xn * r0[1]; lg[2] += xn * r0[2]; lg[3] += xn * r0[3]; lg[4] += xn * r1[0]; lg[5] += xn * r1[1]; lg[6] += xn * r1[2]; lg[7] += xn * r1[3]; }
        }
#pragma unroll
        for (int e = 0; e < 8; ++e) lg[e] = wave_sum(lg[e]);
        if (F.lane == 0) {
            int e0 = 0; float b0 = lg[0];
#pragma unroll
            for (int e = 1; e < 8; ++e) if (lg[e] > b0) { b0 = lg[e]; e0 = e; }
            int e1 = -1; float b1 = -INFINITY;
#pragma unroll
            for (int e = 0; e < 8; ++e) if (e != e0 && lg[e] > b1) { b1 = lg[e]; e1 = e; }
            const float w1 = 1.0f / (1.0f + __expf(b0 - b1)), w0 = 1.0f - w1;
            se[2 * tl] = e0; se[2 * tl + 1] = e1;
            invf[t] = inv; topw[2 * t] = w0; topw[2 * t + 1] = w1;
        }
    }
    LDS_WAIT(); __syncthreads();
    if (F.tid < NE) { int cnt = 0;
        for (int tl = 0; tl < 64; ++tl) { if (se[2 * tl] == F.tid) rk[2 * tl] = cnt++; if (se[2 * tl + 1] == F.tid) rk[2 * tl + 1] = cnt++; }
        ((int*)(ws + WS_WGCNT))[wg * 8 + F.tid] = cnt; }
    LDS_WAIT(); __syncthreads();
    if (F.tid < 128) { ((int*)(ws + WS_TOPE))[t0 * 2 + F.tid] = se[F.tid]; ((int*)(ws + WS_RANK))[t0 * 2 + F.tid] = rk[F.tid]; }
    LDS_WAIT(); __syncthreads();
}
__device__ __forceinline__ void route_pass2(Frame& F_, unsigned char* ws, const float* H) {
    Frame F = F_; F.lane = lane_id_opaque(); F.tid = F.wave * 64 + F.lane;
    const int wg = blockIdx.x, t0 = wg * 64;
    LAS int* cnt = (LAS int*)(F.lds + RING_OFF);
    LAS int* tot = cnt + 2048; LAS int* pre = tot + 8; LAS int* wgoff = pre + 8;
    const int* wgcnt = (const int*)(ws + WS_WGCNT);
    for (int i = F.tid; i < 2048; i += 512) cnt[i] = wgcnt[i];
    LDS_WAIT(); __syncthreads();
    if (F.tid < NE) { int tt = 0, pp = 0; for (int w = 0; w < 256; ++w) { const int c = cnt[w * 8 + F.tid]; pp += (w < wg) ? c : 0; tt += c; } tot[F.tid] = tt; pre[F.tid] = pp; }
    LDS_WAIT(); __syncthreads();
    if (F.tid == 0) { int eb = 0; for (int e = 0; e < NE; ++e) { F.MISC[16 + e] = (unsigned)(eb >> 8); wgoff[e] = eb + pre[e]; eb += (tot[e] + 255) & ~255; } F.MISC[24] = (unsigned)(eb >> 8); }
    LDS_WAIT(); __syncthreads();
    const int* tope = (const int*)(ws + WS_TOPE); const int* rank = (const int*)(ws + WS_RANK); const float* invf = (const float*)(ws + WS_INVF);
    int* slot = (int*)(ws + WS_SLOT); bf16_t* xp = (bf16_t*)(ws + WS_XP);
    for (int i = 0; i < 8; ++i) {
        const int t = t0 + F.wave * 8 + i;
        const int s0 = wgoff[tope[2 * t]] + rank[2 * t], s1 = wgoff[tope[2 * t + 1]] + rank[2 * t + 1];
        const float inv = invf[t];
        const f32x4* hr = (const f32x4*)(H + (size_t)t * D) + F.lane;
        u32x2* o0 = (u32x2*)(xp + (size_t)s0 * D) + F.lane; u32x2* o1 = (u32x2*)(xp + (size_t)s1 * D) + F.lane;
#pragma unroll
        for (int j = 0; j < 4; ++j) { const f32x4 v = hr[64 * j] * inv; u32x2 w; w.x = pk2(v[0], v[1]); w.y = pk2(v[2], v[3]); o0[64 * j] = w; o1[64 * j] = w; }
        if (F.lane == 0) { slot[2 * t] = s0; slot[2 * t + 1] = s1; }
    }
    LDS_WAIT(); __syncthreads();
}
__device__ __forceinline__ void final_pass(Frame& F_, unsigned char* ws, float* H, const float* gain) {
    Frame F = F_; F.lane = lane_id_opaque(); F.tid = F.wave * 64 + F.lane;
    const int gw = F.vcu * NWAVES + F.wave, NGW = F.G * NWAVES;
    const int* slot = (const int*)(ws + WS_SLOT); const float* topw = (const float*)(ws + WS_TOPW); const bf16_t* yp = (const bf16_t*)(ws + WS_YP);
    for (int t = gw; t < M; t += NGW) {
        const int s0 = slot[2 * t], s1 = slot[2 * t + 1]; const float w0 = topw[2 * t], w1 = topw[2 * t + 1];
        f32x4* hr = (f32x4*)(H + (size_t)t * D) + F.lane;
        const u32x2* y0 = (const u32x2*)(yp + (size_t)s0 * D) + F.lane; const u32x2* y1 = (const u32x2*)(yp + (size_t)s1 * D) + F.lane;
        f32x4 v[4]; float s = 0.f;
#pragma unroll
        for (int j = 0; j < 4; ++j) { const u32x2 a = y0[64 * j], b = y1[64 * j]; v[j] = hr[64 * j];
            v[j][0] += w0 * bflo(a.x) + w1 * bflo(b.x); v[j][1] += w0 * bfhi(a.x) + w1 * bfhi(b.x); v[j][2] += w0 * bflo(a.y) + w1 * bflo(b.y); v[j][3] += w0 * bfhi(a.y) + w1 * bfhi(b.y);
            s += (v[j][0] * v[j][0] + v[j][1] * v[j][1]) + (v[j][2] * v[j][2] + v[j][3] * v[j][3]); }
        s = wave_sum(s);
        const float inv = rsqrtf(s * (1.0f / D) + EPS);
#pragma unroll
        for (int j = 0; j < 4; ++j) { const f32x4 g4 = *((const f32x4*)gain + F.lane + 64 * j); hr[64 * j] = (v[j] * inv) * g4; }
    }
}

__device__ __forceinline__ unsigned long long karg(int idx) {
    const __attribute__((address_space(4))) unsigned long long* p = (const __attribute__((address_space(4))) unsigned long long*)__builtin_amdgcn_kernarg_segment_ptr();
    asm volatile("" : "+s"(p));
    return p[idx];
}
__device__ __forceinline__ int opq(int v) { asm volatile("" : "+s"(v)); return v; }
#define KIN(i) ((const float*)(const GAS float*)karg(i))
#define KOUT() ((float*)(GAS float*)karg(22))
#define KWS() ((unsigned char*)(GAS unsigned char*)karg(23))

#define GRID_BAR() xcd_barrier(bar, F.wave)
template <int l>
__device__ __forceinline__ void layer_body(Frame& F, const XcdBarrier& bar, const int cid) {
        { unsigned char* ws = KWS(); pg8::StaticOrder S; S.init(M / 256, NV1 / 256, opq(F.G), opq(cid));
          EpiProj E{ws, KIN(4) + l * 2048};
          run_gemm<FASTG(GP_PROJ), true>(F.lds, (const bf16_t*)(ws + WS_HB), (const bf16_t*)(ws + WS_MW + l * MW_LAYER + MW_WIN), 0, D, S, E, WProj{KIN(3) + (size_t)l * D * INC, KIN(2) + l * D}, F.wave); }
        GRID_BAR();
        { unsigned char* ws = KWS(); pg8::StaticOrder S; S.init(M / 256, 1536 / 256, opq(F.G), opq(cid)); EpiQ E{ws};
          run_gemm<FASTG(GP_QUP), true>(F.lds, (const bf16_t*)(ws + WS_CQ), (const bf16_t*)(ws + WS_MW + l * MW_LAYER + MW_WUQ), 0, QL, S, E, WQ{KIN(9) + (size_t)l * QL * 1536, KIN(7) + l * QL}, F.wave); }
        { unsigned char* ws = KWS(); pg8::StaticOrder S; S.init(M / 256, 2048 / 256, opq(F.G), opq(cid)); EpiKV E{ws};
          run_gemm<FASTG(GP_KVUP), true>(F.lds, (const bf16_t*)(ws + WS_CKV), (const bf16_t*)(ws + WS_MW + l * MW_LAYER + MW_WUKV), 0, KVL, S, E, WKV{KIN(10) + (size_t)l * KVL * 2048, KIN(8) + l * KVL}, F.wave); }
        conv_pass(F, KWS(), KIN(5) + l * 3 * 1024);
        GRID_BAR();
        if (FAST_ATTN) attn::attn_phase(F.lds, KWS(), F.vcu, F.wave); else naive_attention(F, KWS());
        GRID_BAR();
        { unsigned char* ws = KWS(); pg8::StaticOrder S; S.init(M / 256, 4, opq(F.G), opq(cid)); EpiGate<0> E{ws};
          run_gemm<FASTG(GP_CONVOUT), false>(F.lds, (const bf16_t*)(ws + WS_GB), (const bf16_t*)(ws + WS_MW + l * MW_LAYER + MW_WCO), 0, D, S, E, WPlain{KIN(6) + (size_t)l * D * D, D, 0}, F.wave); }
        VM_WAIT(); __syncthreads();
        { unsigned char* ws = KWS(); pg8::StaticOrder S; S.init(M / 256, 4, opq(F.G), opq(cid)); EpiGate<1> E{ws};
          run_gemm<FASTG(GP_ATTNOUT), false>(F.lds, (const bf16_t*)(ws + WS_O), (const bf16_t*)(ws + WS_MW + l * MW_LAYER + MW_WAO), 0, D, S, E, WPlain{KIN(11) + (size_t)l * D * D, D, 0}, F.wave); }
        GRID_BAR();
        { unsigned char* ws = KWS(); pg8::StaticOrder S; S.init(M / 256, 4, opq(F.G), opq(cid)); EpiResid E{l == 0 ? KIN(0) : (const float*)KOUT(), KOUT(), ws};
          run_gemm<FASTG(GP_MIXOUT), false>(F.lds, (const bf16_t*)(ws + WS_MX), (const bf16_t*)(ws + WS_MW + l * MW_LAYER + MW_WMX), 0, D, S, E, WPlain{KIN(12) + (size_t)l * D * D, D, 0}, F.wave); }
        GRID_BAR();
        if (l == 0) {
            { unsigned char* ws = KWS(); pg8::StaticOrder S; S.init(M / 256, 22, opq(F.G), opq(cid)); EpiSwiglu E{(const float*)(ws + WS_SSQH), (bf16_t*)(ws + WS_ACT), FFD};
              run_gemm<FASTG(GP_FFUP), true>(F.lds, (const bf16_t*)(ws + WS_HB), (const bf16_t*)(ws + WS_WGU), 0, D, S, E, WGU{KIN(14), KIN(15), KIN(13) + l * D, FFD, 0}, F.wave); }
            GRID_BAR();
            { unsigned char* ws = KWS(); pg8::StaticOrder S; S.init(M / 256, 4, opq(F.G), opq(cid)); EpiResid E{KOUT(), KOUT(), ws};
              run_gemm<FASTG(GP_FFDOWN), false>(F.lds, (const bf16_t*)(ws + WS_ACT), (const bf16_t*)(ws + WS_WD), 0, FFD, S, E, WPlain{KIN(16), D, 0}, F.wave); }
            GRID_BAR();
        } else {
            route_pass1(F, KWS(), KOUT(), KIN(13) + l * D, KIN(17));
            { int itb = 0; if (FASTG(GP_MOEUP)) prep_weight(F, WGU{KIN(18), KIN(19), KIN(13) + l * D, FFE, (size_t)D * FFE}, D, 2 * FFE, NE, (bf16_t*)(KWS() + WS_WGUE), (size_t)3584 * D, itb); }
            GRID_BAR();
            route_pass2(F, KWS(), KOUT());
            { int itb = 0; if (FASTG(GP_MOEDOWN)) prep_weight(F, WPlain{KIN(20), D, (size_t)FFE * D}, FFE, D, NE, (bf16_t*)(KWS() + WS_WDE), (size_t)D * FFE, itb); }
            GRID_BAR();
            { unsigned char* ws = KWS(); pg8::StaticOrder S; S.init((int)F.MISC[24], 14, opq(F.G), opq(cid), F.MISC + 16); EpiSwiglu E{nullptr, (bf16_t*)(ws + WS_ACTE), FFE};
              run_gemm<FASTG(GP_MOEUP), true>(F.lds, (const bf16_t*)(ws + WS_XP), (const bf16_t*)(ws + WS_WGUE), (size_t)3584 * D, D, S, E, WGU{KIN(18), KIN(19), KIN(13) + l * D, FFE, (size_t)D * FFE}, F.wave); }
            GRID_BAR();
            { unsigned char* ws = KWS(); pg8::StaticOrder S; S.init((int)F.MISC[24], 4, opq(F.G), opq(cid), F.MISC + 16); EpiStore E{(bf16_t*)(ws + WS_YP), D};
              run_gemm<FASTG(GP_MOEDOWN), true>(F.lds, (const bf16_t*)(ws + WS_ACTE), (const bf16_t*)(ws + WS_WDE), (size_t)D * FFE, FFE, S, E, WPlain{KIN(20), D, (size_t)FFE * D}, F.wave); }
            GRID_BAR();
            final_pass(F, KWS(), KOUT(), KIN(21));
        }
}

__global__ void __launch_bounds__(NWAVES * 64, 2) mk_fwd(Args args) {
    extern __shared__ __attribute__((aligned(16))) unsigned char lds[];
    Frame F;
    F.lds = (LAS unsigned char*)lds; F.MISC = (volatile LAS unsigned*)(F.lds + MISC_OFF);
    F.tid = threadIdx.x; F.lane = F.tid & 63; F.wave = __builtin_amdgcn_readfirstlane((int)threadIdx.x >> 6);
    F.G = gridDim.x; { const int bx = blockIdx.x; F.vcu = (F.G % 8 == 0) ? (bx % 8) * (F.G / 8) + bx / 8 : bx; }
    for (int u = F.tid; u < (LDS_BYTES - LDSCTL_OFF) / 4; u += NWAVES * 64) ((LAS unsigned*)(F.lds + LDSCTL_OFF))[u] = 0u;
    __syncthreads();
    XcdBarrier bar = xcd_barrier_post((unsigned*)(args.ws + WS_CTL) + CW_BAR, F.MISC + 8);
    const int cid = (int)blockIdx.x;

    p0_rows(F, KWS(), KIN(0), (const int*)KIN(1));
    { int itb = 0;
#pragma unroll 1
      for (int l = 0; l < 2; ++l) {
        bf16_t* mw = (bf16_t*)(KWS() + WS_MW + l * MW_LAYER);
        if (FASTG(GP_PROJ)) prep_weight(F, WProj{KIN(3) + (size_t)l * D * INC, KIN(2) + l * D}, D, NV1, 1, mw + MW_WIN / 2, 0, itb);
        if (FASTG(GP_CONVOUT)) prep_weight(F, WPlain{KIN(6) + (size_t)l * D * D, D, 0}, D, D, 1, mw + MW_WCO / 2, 0, itb);
        if (FASTG(GP_ATTNOUT)) prep_weight(F, WPlain{KIN(11) + (size_t)l * D * D, D, 0}, D, D, 1, mw + MW_WAO / 2, 0, itb);
        if (FASTG(GP_MIXOUT)) prep_weight(F, WPlain{KIN(12) + (size_t)l * D * D, D, 0}, D, D, 1, mw + MW_WMX / 2, 0, itb);
        if (FASTG(GP_QUP)) prep_weight(F, WQ{KIN(9) + (size_t)l * QL * 1536, KIN(7) + l * QL}, QL, 1536, 1, mw + MW_WUQ / 2, 0, itb);
        if (FASTG(GP_KVUP)) prep_weight(F, WKV{KIN(10) + (size_t)l * KVL * 2048, KIN(8) + l * KVL}, KVL, 2048, 1, mw + MW_WUKV / 2, 0, itb);
      }
      if (FASTG(GP_FFUP)) prep_weight(F, WGU{KIN(14), KIN(15), KIN(13), FFD, 0}, D, 2 * FFD, 1, (bf16_t*)(KWS() + WS_WGU), 0, itb);
      if (FASTG(GP_FFDOWN)) prep_weight(F, WPlain{KIN(16), D, 0}, FFD, D, 1, (bf16_t*)(KWS() + WS_WD), 0, itb);
    }
    GRID_BAR();

    layer_body<0>(F, bar, cid);
    layer_body<1>(F, bar, cid);
}

extern "C" void kernel_launch(void* const* d_in, const int* in_sizes, int n_in, void* d_out, int out_size, void* d_ws, size_t ws_size, hipStream_t stream) {
    static int grid = 0;
    if (grid == 0) {
        if (n_in != 22 || in_sizes[0] != M * D || out_size != M * D || ws_size < WS_END) { fprintf(stderr, "kernel_launch: unexpected shapes (n_in %d, out %d, ws %zu < %zu)\n", n_in, out_size, ws_size, (size_t)WS_END); grid = -1; return; }
        int dev = 0, cus = 0;
        if (hipGetDevice(&dev) != hipSuccess || hipDeviceGetAttribute(&cus, hipDeviceAttributeMultiprocessorCount, dev) != hipSuccess) { grid = -1; return; }
        if (hipFuncSetAttribute((const void*)mk_fwd, hipFuncAttributeMaxDynamicSharedMemorySize, LDS_BYTES) != hipSuccess) { fprintf(stderr, "kernel_launch: hipFuncSetAttribute failed\n"); grid = -1; return; }
        (void)hipGetLastError();
        grid = cus;
        if (grid != 256) { fprintf(stderr, "kernel_launch: built for 256 CUs, found %d\n", cus); grid = -1; return; }
    }
    if (grid < 0) return;
    (void)hipMemsetAsync((char*)d_ws + WS_CTL, 0, CTL_ZERO_BYTES, stream);
    Args a{};
    for (int i = 0; i < 22; ++i) a.in[i] = (const float*)d_in[i];
    a.out = (float*)d_out; a.ws = (unsigned char*)d_ws;
    hipLaunchKernelGGL(mk_fwd, dim3(grid), dim3(NWAVES * 64), LDS_BYTES, stream, a);
}
```
